# Optimizing an MI355X kernel written in HIP

```python
import math
import jax
import jax.numpy as jnp
from jax import lax
import numpy as np

D_MODEL = 2048
BATCH = 4
SEQ = 2048
DEPTH = 1

N_META = 16
EPS = 1e-6

GLA_HEADS = 4
GLA_DK = D_MODEL // (2 * GLA_HEADS)
GLA_DV = D_MODEL // GLA_HEADS
GLA_QK = GLA_HEADS * GLA_DK
GLA_V = GLA_HEADS * GLA_DV
GLA_LOWRANK = 16
GLA_TAU = 16.0
GLA_CHUNK = 64
GLA_FRONT_PAD = GLA_CHUNK - N_META

DIFF_HEADS = 8
DIFF_DH = D_MODEL // (2 * DIFF_HEADS)
DIFF_DV = 2 * DIFF_DH
DIFF_QK = DIFF_HEADS * 2 * DIFF_DH
DIFF_V = DIFF_HEADS * DIFF_DV
Q_BLOCK = 128

ROPE_THETA = 500000.0
ROPE_DIMS = DIFF_DH // 4

PEER_HEADS = 8
PEER_NKEYS = 128
PEER_N = PEER_NKEYS * PEER_NKEYS
PEER_DKEY = 128
PEER_TOPK = 16
PEER_TOKEN_BLOCK = 64

IN_SIZES = (GLA_QK, GLA_QK, GLA_V, GLA_V, 2 * GLA_LOWRANK, DIFF_QK, DIFF_QK, DIFF_V, D_MODEL, D_MODEL)
IN_WIDTH = sum(IN_SIZES)

kernel_name = 'hybrid_gla_diffattn_peer_encoder'


def rmsnorm(x, g):
    xf = x.astype(jnp.float32)
    y = xf * lax.rsqrt(jnp.mean(xf * xf, axis=-1, keepdims=True) + EPS)
    return (y * g.astype(jnp.float32)).astype(x.dtype)


def split_points(sizes):
    pts, acc = [], 0
    for s in sizes[:-1]:
        acc += s
        pts.append(acc)
    return pts


def partial_rope(x, pos):
    half = ROPE_DIMS // 2
    inv = 1.0 / (ROPE_THETA ** (jnp.arange(half, dtype=jnp.float32) / half))
    ang = pos.astype(jnp.float32)[:, None] * inv[None, :]
    cos = jnp.cos(ang).astype(x.dtype)
    sin = jnp.sin(ang).astype(x.dtype)
    x1 = x[..., :half]
    x2 = x[..., half:ROPE_DIMS]
    return jnp.concatenate([x1 * cos - x2 * sin, x1 * sin + x2 * cos, x[..., ROPE_DIMS:]], axis=-1)


def gla_direction(q, k, v, logf, inclusive):
    C = q.shape[-2]
    b = jnp.cumsum(logf, axis=-2)
    b_last = b[..., -1:, :]
    q_in = q * jnp.exp(b)
    k_in = k * jnp.exp(-b)
    k_st = k * jnp.exp(b_last - b)
    mask = jnp.tril(jnp.ones((C, C), dtype=bool), 0 if inclusive else -1)
    a = jnp.where(mask, jnp.einsum('bhntd,bhnsd->bhnts', q_in, k_in), 0.0)
    o_intra = jnp.einsum('bhnts,bhnse->bhnte', a, v)
    d_state = jnp.einsum('bhnsd,bhnse->nbhde', k_st, v)
    decay = jnp.moveaxis(jnp.exp(b_last[..., 0, :]), 2, 0)

    def step(s, inp):
        dec, ds = inp
        return s * dec[..., None] + ds, s

    s0 = jnp.zeros(d_state.shape[1:], d_state.dtype)
    _, s_in = lax.scan(step, s0, (decay, d_state))
    o_inter = jnp.einsum('bhntd,nbhde->bhnte', q_in, s_in)
    return o_intra + o_inter


def gla_mixer(q, k, v, r, lr, w2_f, b_f, w2_b, b_b, g_norm):
    B, L, _ = q.shape
    C = GLA_CHUNK
    lr_f, lr_b = jnp.split(lr, 2, axis=-1)
    logf_f = jax.nn.log_sigmoid((lr_f @ w2_f + b_f).astype(jnp.float32)) / GLA_TAU
    logf_b = jax.nn.log_sigmoid((lr_b @ w2_b + b_b).astype(jnp.float32)) / GLA_TAU
    Lp = L + GLA_FRONT_PAD
    N = Lp // C

    def heads(t, dh):
        t = jnp.pad(t, ((0, 0), (GLA_FRONT_PAD, 0), (0, 0)))
        return t.reshape(B, N, C, GLA_HEADS, dh).transpose(0, 3, 1, 2, 4)

    qh = heads(q * (GLA_DK ** -0.5), GLA_DK)
    kh = heads(k, GLA_DK)
    vh = heads(v, GLA_DV)
    ff = heads(logf_f, GLA_DK)
    fb = heads(logf_b, GLA_DK)
    flip = lambda t: jnp.flip(t, axis=(2, 3))
    o = gla_direction(qh, kh, vh, ff, True) + flip(gla_direction(flip(qh), flip(kh), flip(vh), flip(fb), False))
    o = o.transpose(0, 2, 3, 1, 4).reshape(B, Lp, GLA_HEADS, GLA_DV)[:, GLA_FRONT_PAD:]
    o = rmsnorm(o, g_norm).reshape(B, L, GLA_V)
    return (o * jax.nn.silu(r.astype(jnp.float32))).astype(v.dtype)


def diff_attention(q, k, v, pos, lq1, lk1, lq2, lk2, g_norm, lam_init):
    B, L, _ = q.shape
    qh = partial_rope(q.reshape(B, L, DIFF_HEADS, 2, DIFF_DH).transpose(3, 0, 2, 1, 4), pos)
    kh = partial_rope(k.reshape(B, L, DIFF_HEADS, 2, DIFF_DH).transpose(3, 0, 2, 1, 4), pos)
    vh = v.reshape(B, L, DIFF_HEADS, DIFF_DV).transpose(0, 2, 1, 3)
    lam = (jnp.exp(jnp.sum(lq1.astype(jnp.float32) * lk1.astype(jnp.float32)))
           - jnp.exp(jnp.sum(lq2.astype(jnp.float32) * lk2.astype(jnp.float32))) + lam_init)
    n_blk = -(-L // Q_BLOCK)
    Lq = n_blk * Q_BLOCK
    qp = jnp.pad(qh, ((0, 0), (0, 0), (0, 0), (0, Lq - L), (0, 0)))
    qb = qp.reshape(2, B, DIFF_HEADS, n_blk, Q_BLOCK, DIFF_DH).transpose(3, 0, 1, 2, 4, 5)
    scale = DIFF_DH ** -0.5

    def block(qblk):
        s = jnp.einsum('ibhqd,ibhkd->ibhqk', qblk, kh, preferred_element_type=jnp.float32) * scale
        p = jax.nn.softmax(s, axis=-1)
        w = p[0] - lam * p[1]
        return jnp.einsum('bhqk,bhke->bhqe', w.astype(vh.dtype), vh)

    o = lax.map(block, qb)
    o = o.transpose(1, 0, 3, 2, 4).reshape(B, Lq, DIFF_HEADS, DIFF_DV)[:, :L]
    o = rmsnorm(o, g_norm) * (1.0 - lam_init)
    return o.reshape(B, L, DIFF_V).astype(v.dtype)


def peer(h, w_q, sub_keys, u_tab, v_tab):
    B, L, D = h.shape
    T = B * L
    TB = PEER_TOKEN_BLOCK
    n_blk = -(-T // TB)
    xp = jnp.pad(h.reshape(T, D), ((0, n_blk * TB - T), (0, 0))).reshape(n_blk, TB, D)
    K = PEER_TOPK

    def block(xb):
        qb = (xb @ w_q).reshape(TB, PEER_HEADS, 2, PEER_DKEY)
        s = jnp.einsum('thpc,hpnc->thpn', qb, sub_keys).astype(jnp.float32)
        sv, si = lax.top_k(s, K)
        cand = (sv[:, :, 0, :, None] + sv[:, :, 1, None, :]).reshape(TB, PEER_HEADS, K * K)
        cidx = (si[:, :, 0, :, None] * PEER_NKEYS + si[:, :, 1, None, :]).reshape(TB, PEER_HEADS, K * K)
        cv, ci = lax.top_k(cand, K)
        eidx = jnp.take_along_axis(cidx, ci, axis=-1)
        g = jax.nn.softmax(cv, axis=-1)
        u = u_tab[eidx]
        vv = v_tab[eidx]
        a = jax.nn.gelu(jnp.einsum('thkd,td->thk', u, xb).astype(jnp.float32), approximate=False)
        return jnp.einsum('thk,thkd->td', (g * a).astype(vv.dtype), vv)

    out = lax.map(block, xp).reshape(n_blk * TB, D)[:T]
    return out.reshape(B, L, D)


def setup_inputs(seed: int = 0) -> dict:
    key = jax.random.key(seed)
    ks = jax.random.split(key, 24)
    nrm = lambda k, shape, s: jax.random.normal(k, shape, jnp.float32) * s
    gain = lambda k, shape: 1.0 + 0.02 * jax.random.normal(k, shape, jnp.float32)
    P = DEPTH
    return {
        'x': nrm(ks[0], (BATCH, SEQ, D_MODEL), 1.0),
        'meta_tokens': nrm(ks[1], (N_META, D_MODEL), 1.0),
        'g_mix': gain(ks[2], (P, D_MODEL)),
        'w_in': nrm(ks[3], (P, D_MODEL, IN_WIDTH), D_MODEL ** -0.5),
        'gla_w2_fwd': nrm(ks[4], (P, GLA_LOWRANK, GLA_QK), GLA_LOWRANK ** -0.5),
        'gla_b_fwd': nrm(ks[5], (P, GLA_QK), 0.1),
        'gla_w2_bwd': nrm(ks[6], (P, GLA_LOWRANK, GLA_QK), GLA_LOWRANK ** -0.5),
        'gla_b_bwd': nrm(ks[7], (P, GLA_QK), 0.1),
        'gla_g_norm': gain(ks[8], (P, GLA_DV)),
        'diff_lq1': nrm(ks[9], (P, DIFF_DH), 0.1),
        'diff_lk1': nrm(ks[10], (P, DIFF_DH), 0.1),
        'diff_lq2': nrm(ks[11], (P, DIFF_DH), 0.1),
        'diff_lk2': nrm(ks[12], (P, DIFF_DH), 0.1),
        'diff_g_norm': gain(ks[13], (P, DIFF_DV)),
        'w_branch_gla': nrm(ks[14], (P, GLA_V, D_MODEL), GLA_V ** -0.5),
        'w_branch_diff': nrm(ks[15], (P, DIFF_V, D_MODEL), DIFF_V ** -0.5),
        'w_out': nrm(ks[16], (P, D_MODEL, D_MODEL), D_MODEL ** -0.5),
        'g_ffn': gain(ks[17], (P, D_MODEL)),
        'peer_w_q': nrm(ks[18], (P, D_MODEL, PEER_HEADS * 2 * PEER_DKEY), D_MODEL ** -0.5),
        'peer_sub_keys': nrm(ks[19], (P, PEER_HEADS, 2, PEER_NKEYS, PEER_DKEY), PEER_DKEY ** -0.5),
        'peer_u': nrm(ks[20], (P, PEER_N, D_MODEL), D_MODEL ** -0.5),
        'peer_v': nrm(ks[21], (P, PEER_N, D_MODEL), 0.25),
        'g_final': gain(ks[22], (D_MODEL,)),
    }


def reference(x, meta_tokens, g_mix, w_in, gla_w2_fwd, gla_b_fwd, gla_w2_bwd, gla_b_bwd, gla_g_norm,
              diff_lq1, diff_lk1, diff_lq2, diff_lk2, diff_g_norm, w_branch_gla, w_branch_diff, w_out,
              g_ffn, peer_w_q, peer_sub_keys, peer_u, peer_v, g_final):
    B = x.shape[0]
    meta = jnp.broadcast_to(meta_tokens[None].astype(x.dtype), (B, N_META, D_MODEL))
    hs = jnp.concatenate([meta, x], axis=1)
    L = hs.shape[1]
    pos = jnp.arange(L, dtype=jnp.int32)
    pts = split_points(IN_SIZES)
    for l in range(DEPTH):
        lam_init = 0.8 - 0.6 * math.exp(-0.3 * l)
        h = rmsnorm(hs, g_mix[l])
        gq, gk, gv, gr, glr, dq, dk, dv, za, zb = jnp.split(h @ w_in[l], pts, axis=-1)
        o_gla = gla_mixer(gq, gk, gv, gr, glr, gla_w2_fwd[l], gla_b_fwd[l], gla_w2_bwd[l], gla_b_bwd[l],
                          gla_g_norm[l])
        o_diff = diff_attention(dq, dk, dv, pos, diff_lq1[l], diff_lk1[l], diff_lq2[l], diff_lk2[l],
                                diff_g_norm[l], lam_init)
        y = jax.nn.sigmoid(za) * (o_gla @ w_branch_gla[l]) + jax.nn.sigmoid(zb) * (o_diff @ w_branch_diff[l])
        hs = hs + y @ w_out[l]
        hs = hs + peer(rmsnorm(hs, g_ffn[l]), peer_w_q[l], peer_sub_keys[l], peer_u[l], peer_v[l])
    out = rmsnorm(hs, g_final)
    return out[:, N_META:]
```

```cpp
#include <hip/hip_runtime.h>
#include <hip/hip_cooperative_groups.h>
#include <cstdio>
#include <cstdint>
namespace cg = cooperative_groups;
namespace pg8 {
#define PG8_LAS __attribute__((address_space(3)))
typedef unsigned short bf16_t;
typedef short bf16x8 __attribute__((ext_vector_type(8)));
typedef float f32x4 __attribute__((ext_vector_type(4)));
typedef unsigned u32x4 __attribute__((ext_vector_type(4)));
constexpr int BM = 256, BK = 64, HALF = 128, HTB = HALF * BK * 2  , STAGE_BYTES = 8 * HTB, NXCD = 8, WGM = 8;

__host__ __device__ __forceinline__ int lds_byte(int r, int c) { const int st = (r >> 4) * 2 + (c >> 5), rr = r & 15, cc = c & 31, ob = rr * 64 + cc * 2; return st * 1024 + (ob ^ (((ob >> 9) & 1) << 5)); }
__host__ __device__ __forceinline__ void stage_rc(int b, int& R, int& C) { const int st = b / 1024, sb = b % 1024, swz = sb ^ (((sb >> 9) & 1) << 5); R = (st >> 1) * 16 + swz / 64; C = (st & 1) * 32 + (swz % 64) / 2; }
__host__ __device__ __forceinline__ int perm32(int rho) { const int n = rho >> 4, i = rho & 15; return 8 * (i >> 2) + 4 * n + (i & 3); }

struct Unit { int pm, pn; };
struct Gemm { const bf16_t* A; const bf16_t* Bt; int M, N, K; };

struct StaticOrder {
    int nM, nN, nwg, G, c;
    __host__ __device__ void init(int M, int N, int G_, int c_) { nM = M / BM; nN = N / BM; nwg = nM * nN; G = G_; c = c_; }
    __host__ __device__ __forceinline__ bool next(int i, Unit& u) const {
        const long L = (long)i * G + c; if (L >= nwg) return false;
        int wgid = (int)L; { const int q = nwg / NXCD, r = nwg % NXCD, xcd = wgid % NXCD, off = wgid / NXCD; wgid = (xcd < r ? xcd * (q + 1) : r * (q + 1) + (xcd - r) * q) + off; }
        const int nig = WGM * nN, gid = wgid / nig, fm = gid * WGM, gsz = (nM - fm) < WGM ? (nM - fm) : WGM;
        u.pm = fm + ((wgid % nig) % gsz); u.pn = (wgid % nig) / gsz; return true;
    }
    __device__ __forceinline__ void a_ready(const Unit&) const {}
    __device__ __forceinline__ void done(const Unit&) const {}
};

template <class Epi, class Sched, bool ALIGN_EPI = false, bool SP2 = false>
__device__ __forceinline__ void gemm_phase(PG8_LAS unsigned char* lds, const Gemm g, const Sched& S, const Epi& E) {
    const int tid = threadIdx.x, wid = __builtin_amdgcn_readfirstlane(tid >> 6), lane = tid & 63, wr = wid >> 2, wc = wid & 3, fr = lane & 15, fq = lane >> 4;
    const int K = g.K, nt = K / BK;
    unsigned voffA[2], voffB[2];
#pragma unroll
    for (int i = 0; i < 2; ++i) { int R, C; stage_rc(tid * 16 + i * 8192, R, C); const int Rb = Epi::PERM ? ((R & ~31) + perm32(R & 31)) : R;
        voffA[i] = (unsigned)(R * K + C) * 2u; voffB[i] = (unsigned)(Rb * K + C) * 2u; }
    const size_t kstep = (size_t)(BK * 2);
    const size_t hstep = (size_t)HALF * K * 2;
    const size_t tstep = 2 * hstep;
    const unsigned ldsw = (unsigned)wid * 1024u;
    const int aoff = lds_byte(wr * 64 + fr, fq * 8), boff = lds_byte(wc * 32 + fr, fq * 8);
#define PG8_SA(b, h) (((b) * 2 + (h)) * HTB)
#define PG8_SB(b, h) ((4 + (b) * 2 + (h)) * HTB)
#define PG8_STAGE(bufoff, gbase, voff) do { _Pragma("unroll") for (int _i = 0; _i < 2; ++_i) \
        __builtin_amdgcn_global_load_lds((const unsigned*)((const char*)(gbase) + (voff)[_i]), (PG8_LAS unsigned*)(lds + (bufoff) + ldsw + _i * 8192), 16, 0, 0); } while (0)
#define PG8_LDA(dst, b, h) do { _Pragma("unroll") for (int m = 0; m < 4; ++m) _Pragma("unroll") for (int k = 0; k < 2; ++k) dst[m][k] = *(const PG8_LAS bf16x8*)(lds + PG8_SA(b, h) + aoff + m * 2048 + k * 1024); } while (0)
#define PG8_LDB(dst, b, h) do { _Pragma("unroll") for (int n = 0; n < 2; ++n) _Pragma("unroll") for (int k = 0; k < 2; ++k) dst[n][k] = *(const PG8_LAS bf16x8*)(lds + PG8_SB(b, h) + boff + n * 2048 + k * 1024); } while (0)
#define PG8_MMA(ai, bj, At, Bt) do { __builtin_amdgcn_s_setprio(1); _Pragma("unroll") for (int m = 0; m < 4; ++m) _Pragma("unroll") for (int n = 0; n < 2; ++n) _Pragma("unroll") for (int k = 0; k < 2; ++k) \
        acc[ai][bj][m][n] = __builtin_amdgcn_mfma_f32_16x16x32_bf16(Bt[n][k], At[m][k], acc[ai][bj][m][n], 0, 0, 0); __builtin_amdgcn_s_setprio(0); } while (0)
#define PG8_WAIT_V(n) asm volatile("s_waitcnt vmcnt(" #n ")" ::: "memory")
#define PG8_WAIT_L(n) asm volatile("s_waitcnt lgkmcnt(" #n ")" ::: "memory")
#define PG8_BAR __builtin_amdgcn_s_barrier()
#define PG8_SCHED __builtin_amdgcn_sched_barrier(0)
    Unit cur, nxt; int ui = 0;
    if (!S.next(0, cur)) return;
    f32x4 acc[2][2][4][2];
#pragma unroll
    for (int a = 0; a < 2; ++a)
#pragma unroll
        for (int b = 0; b < 2; ++b)
#pragma unroll
            for (int m = 0; m < 4; ++m)
#pragma unroll
                for (int n = 0; n < 2; ++n) acc[a][b][m][n] = (f32x4){0.f, 0.f, 0.f, 0.f};
    bf16x8 At[4][2], B0[2][2], B1[2][2];
    const char* cA = (const char*)g.A + (size_t)cur.pm * tstep; const char* cB = (const char*)g.Bt + (size_t)cur.pn * tstep;
    S.a_ready(cur);
    if constexpr (SP2) {
        PG8_STAGE(PG8_SB(0, 0), cB, voffB); PG8_STAGE(PG8_SB(0, 1), cB + hstep, voffB); PG8_STAGE(PG8_SA(0, 0), cA, voffA); PG8_STAGE(PG8_SA(0, 1), cA + hstep, voffA);
        if (wr == 1) PG8_BAR;
        PG8_WAIT_V(2); PG8_BAR;
        PG8_STAGE(PG8_SB(1, 0), cB + kstep, voffB); PG8_STAGE(PG8_SA(1, 0), cA + kstep, voffA); PG8_STAGE(PG8_SB(1, 1), cB + hstep + kstep, voffB);
        PG8_WAIT_V(6); PG8_BAR;
    } else {
        PG8_STAGE(PG8_SB(0, 0), cB, voffB); PG8_STAGE(PG8_SA(0, 0), cA, voffA); PG8_STAGE(PG8_SB(0, 1), cB + hstep, voffB); PG8_STAGE(PG8_SA(0, 1), cA + hstep, voffA);
        if (wr == 1) PG8_BAR;
        PG8_WAIT_V(4); PG8_BAR;
        PG8_STAGE(PG8_SB(1, 0), cB + kstep, voffB); PG8_STAGE(PG8_SA(1, 0), cA + kstep, voffA); PG8_STAGE(PG8_SB(1, 1), cB + hstep + kstep, voffB);
        PG8_WAIT_V(6); PG8_BAR;
    }
    for (;;) {
        const bool has_next = S.next(ui + 1, nxt);
        const char* nA = has_next ? (const char*)g.A + (size_t)nxt.pm * tstep : cA; const char* nB = has_next ? (const char*)g.Bt + (size_t)nxt.pn * tstep : cB;
        for (int t = 0; t < nt; t += 2) {
            const bool last = (t == nt - 2);
            const char* a1 = cA + (size_t)(t + 1) * kstep;
            const char* a2 = last ? nA : cA + (size_t)(t + 2) * kstep; const char* b2 = last ? nB : cB + (size_t)(t + 2) * kstep;
            const char* a3 = a2 + kstep; const char* b3 = b2 + kstep;
            if (last && has_next) S.a_ready(nxt);
            if constexpr (SP2) {
            PG8_LDB(B0, 0, 0); PG8_LDB(B1, 0, 1); PG8_SCHED; PG8_LDA(At, 0, 0); PG8_STAGE(PG8_SA(1, 1), a1 + hstep, voffA);
            PG8_WAIT_V(8); PG8_WAIT_L(0); PG8_BAR; PG8_MMA(0, 0, At, B0); PG8_MMA(0, 1, At, B1); PG8_BAR; PG8_SCHED;
            PG8_LDA(At, 0, 1); PG8_STAGE(PG8_SB(0, 0), b2, voffB); PG8_STAGE(PG8_SB(0, 1), b2 + hstep, voffB); PG8_STAGE(PG8_SA(0, 0), a2, voffA);
            PG8_WAIT_V(8); PG8_WAIT_L(0); PG8_BAR; PG8_MMA(1, 0, At, B0); PG8_MMA(1, 1, At, B1); PG8_BAR; PG8_SCHED;
            PG8_LDB(B0, 1, 0); PG8_LDB(B1, 1, 1); PG8_SCHED; PG8_LDA(At, 1, 0); PG8_STAGE(PG8_SA(0, 1), a2 + hstep, voffA);
            PG8_WAIT_V(8); PG8_WAIT_L(0); PG8_BAR; PG8_MMA(0, 0, At, B0); PG8_MMA(0, 1, At, B1); PG8_BAR; PG8_SCHED;
            PG8_LDA(At, 1, 1); PG8_STAGE(PG8_SB(1, 0), b3, voffB); PG8_STAGE(PG8_SB(1, 1), b3 + hstep, voffB); PG8_STAGE(PG8_SA(1, 0), a3, voffA);
            PG8_WAIT_V(8); PG8_WAIT_L(0); PG8_BAR; PG8_MMA(1, 0, At, B0); PG8_MMA(1, 1, At, B1); PG8_BAR; PG8_SCHED;
            } else {
            PG8_LDB(B0, 0, 0); PG8_SCHED; PG8_LDA(At, 0, 0); PG8_STAGE(PG8_SA(1, 1), a1 + hstep, voffA);
            PG8_WAIT_L(8); PG8_BAR; PG8_WAIT_L(0); PG8_MMA(0, 0, At, B0); PG8_BAR; PG8_SCHED;
            PG8_LDB(B1, 0, 1); PG8_STAGE(PG8_SB(0, 0), b2, voffB);
            PG8_BAR; PG8_WAIT_L(0); PG8_MMA(0, 1, At, B1); PG8_BAR;
            PG8_LDA(At, 0, 1); PG8_STAGE(PG8_SA(0, 0), a2, voffA);
            PG8_BAR; PG8_WAIT_L(0); PG8_MMA(1, 0, At, B0); PG8_BAR; PG8_SCHED;
            PG8_STAGE(PG8_SB(0, 1), b2 + hstep, voffB);
            PG8_WAIT_V(6); PG8_BAR; PG8_MMA(1, 1, At, B1); PG8_BAR;
            PG8_LDB(B0, 1, 0); PG8_SCHED; PG8_LDA(At, 1, 0); PG8_STAGE(PG8_SA(0, 1), a2 + hstep, voffA);
            PG8_WAIT_L(8); PG8_BAR; PG8_WAIT_L(0); PG8_MMA(0, 0, At, B0); PG8_BAR; PG8_SCHED;
            PG8_LDB(B1, 1, 1); PG8_STAGE(PG8_SB(1, 0), b3, voffB);
            PG8_BAR; PG8_WAIT_L(0); PG8_MMA(0, 1, At, B1); PG8_BAR;
            PG8_LDA(At, 1, 1); PG8_STAGE(PG8_SA(1, 0), a3, voffA);
            PG8_BAR; PG8_WAIT_L(0); PG8_MMA(1, 0, At, B0); PG8_BAR; PG8_SCHED;
            PG8_STAGE(PG8_SB(1, 1), b3 + hstep, voffB);
            PG8_WAIT_V(6); PG8_BAR; PG8_MMA(1, 1, At, B1); PG8_BAR;
            }
        }
        if constexpr (ALIGN_EPI) { if (wr == 0) PG8_BAR; }
        if constexpr (!Epi::AFTER_DRAIN) { E(acc, cur, wr, wc, fr, fq); S.done(cur); }
        if (!has_next) break;
#pragma unroll
        for (int a = 0; a < 2; ++a)
#pragma unroll
            for (int b = 0; b < 2; ++b)
#pragma unroll
                for (int m = 0; m < 4; ++m)
#pragma unroll
                    for (int n = 0; n < 2; ++n) acc[a][b][m][n] = (f32x4){0.f, 0.f, 0.f, 0.f};
        cur = nxt; cA = nA; cB = nB; ++ui;
        if constexpr (ALIGN_EPI) { if (wr == 1) PG8_BAR; }
    }
    PG8_WAIT_V(0);
    if constexpr (!ALIGN_EPI) { if (wr == 0) PG8_BAR; }
    PG8_BAR;
    if constexpr (Epi::AFTER_DRAIN) { E.fused(acc, cur, wr, wc, fr, fq, lds, wid, lane); S.done(cur); }
#undef PG8_SA
#undef PG8_SB
#undef PG8_STAGE
#undef PG8_LDA
#undef PG8_LDB
#undef PG8_MMA
#undef PG8_WAIT_V
#undef PG8_WAIT_L
#undef PG8_BAR
#undef PG8_SCHED
}
}

#define LAS __attribute__((address_space(3)))
typedef unsigned short bf16_t;
typedef short bf16x8 __attribute__((ext_vector_type(8)));
typedef short s16x4 __attribute__((ext_vector_type(4)));
typedef float f32x4 __attribute__((ext_vector_type(4)));
typedef float f32x16 __attribute__((ext_vector_type(16)));
typedef unsigned u32x4 __attribute__((ext_vector_type(4)));
typedef unsigned u32x2 __attribute__((ext_vector_type(2)));
typedef float f32x2_t __attribute__((ext_vector_type(2)));
typedef __bf16 bf16x2_t __attribute__((ext_vector_type(2)));
#define DI __device__ __forceinline__
#define LDS_WAIT() asm volatile("s_waitcnt lgkmcnt(0)" ::: "memory")
#define LDS_BARRIER() do { asm volatile("s_waitcnt lgkmcnt(0)" ::: "memory"); __builtin_amdgcn_s_barrier(); asm volatile("" ::: "memory"); } while (0)
#define MFMA16(a, b, c) __builtin_amdgcn_mfma_f32_16x16x32_bf16((a), (b), (c), 0, 0, 0)
#define MFMA32(a, b, c) __builtin_amdgcn_mfma_f32_32x32x16_bf16((a), (b), (c), 0, 0, 0)

DI unsigned pk2(float lo, float hi) { f32x2_t v = {lo, hi}; bf16x2_t b = __builtin_convertvector(v, bf16x2_t); return __builtin_bit_cast(unsigned, b); }
DI bf16_t f2bf(float x) { return (bf16_t)(pk2(x, 0.f) & 0xffffu); }
DI float bf2f(bf16_t b) { return __uint_as_float(((unsigned)b) << 16); }
DI float bflo(unsigned w) { return __uint_as_float(w << 16); }
DI float bfhi(unsigned w) { return __uint_as_float(w & 0xffff0000u); }
DI float wave_sum(float v) {
#pragma unroll
    for (int o = 1; o < 64; o <<= 1) v += __shfl_xor(v, o);
    return v;
}
DI float sigmoidf_(float x) { return 1.0f / (1.0f + __expf(-x)); }
DI float gelu_f(float v) {
    const float av = fabsf(v), d = av * 0.2316418882f + 1.0f; const float t = __builtin_amdgcn_rcpf(d);
    float q = t * 0.5307027145f + (-0.7265760135f); q = q * t + 0.7107068705f; q = q * t + (-0.142248368f); q = q * t + 0.127414796f; q = q * t;
    const float s = (v * v) * (-0.72134752044f); const float e = __builtin_amdgcn_exp2f(s); const float m = v * (q * e), r = v - m; return v < 0.f ? m : r;
}

constexpr int NB = 4, SEQ = 2048, DM = 2048, TR = NB * SEQ;
constexpr int LKP = 2112, LK = 2064;
constexpr int MROWS = 8448, NIN = 16640;
constexpr float EPSN = 1e-6f;
constexpr float C2Q = 0.12751743082459868f;
constexpr int NPH = 10;
constexpr size_t MiB = 1u << 20;
constexpr size_t WS_SSQ = 0, WS_BAR = 65536;
constexpr size_t WS_WTA = 1 * MiB, WS_WTB = 9 * MiB, WS_WTO = 17 * MiB, WS_WTQ = 25 * MiB, WS_KEYS = 33 * MiB, WS_ROPE = 33 * MiB + 512 * 1024, WS_LR = 34 * MiB;
constexpr size_t WS_SA = 36 * MiB, WS_SB = 68 * MiB, WS_R = 100 * MiB, WS_VG = 132 * MiB, WS_QD = 165 * MiB, WS_KD = 197 * MiB, WS_VDT = 230 * MiB;
constexpr size_t WS_WTIN = 263 * MiB, WS_A = 328 * MiB, WS_QG = 361 * MiB, WS_KG = 361 * MiB + 16 * MiB + 512 * 1024, WS_QIN = 394 * MiB, WS_KST = 427 * MiB, WS_AMAT = 460 * MiB;
constexpr size_t WS_DEC = 468 * MiB + 256 * 1024;
constexpr size_t WS_OF = 263 * MiB, WS_OB = 295 * MiB, WS_OG = 394 * MiB, WS_Y1 = 197 * MiB, WS_Y = 230 * MiB, WS_H1 = 263 * MiB, WS_QP = 295 * MiB;
constexpr size_t WS_OD = 361 * MiB;
constexpr size_t WS_IDX = 132 * MiB, WS_GATE = 136 * MiB, WS_U = 470 * MiB, WS_V = 328 * MiB, WS_END = 502 * MiB;
constexpr int LDS_BYTES = 147456;

struct Args { const float* in[23]; float* out; unsigned char* ws; int ph_lo, ph_hi, coop, pad; };
typedef __attribute__((address_space(4))) const unsigned long long cu64_t;
template <int IDX> DI unsigned long long karg64() { unsigned long long v; cu64_t* kp = (cu64_t*)__builtin_amdgcn_kernarg_segment_ptr();
    asm volatile("s_load_dwordx2 %0, %1, %2\n\ts_waitcnt lgkmcnt(0)" : "=s"(v) : "s"(kp), "n"(IDX * 8) : "memory"); return v; }
template <int IDX> DI unsigned char* kptr() { typedef __attribute__((address_space(1))) unsigned char gu8_t; return (unsigned char*)(gu8_t*)karg64<IDX>(); }
#define INP(k) ((const float*)kptr<(k)>())
#define WSB() (kptr<24>())
#define OUTP() ((float*)kptr<23>())

#define XB_TMO      128
#define XB_XCNT(j)  (256  + 64 * (j))
#define XB_XSUB(j)  (1280 + 64 * (j))
#define XB_XGEN(j)  (2304 + 64 * (j))
#define XB_TOP      3328
#define XB_TOPGEN   3392
#define XCD_BAR_WORDS 3456
#define XB_SPIN_CAP (1u << 18)

__device__ __forceinline__ unsigned xb_ld(unsigned* p)              { return __hip_atomic_load(p, __ATOMIC_RELAXED, __HIP_MEMORY_SCOPE_AGENT); }
__device__ __forceinline__ unsigned xb_add(unsigned* p, unsigned v) { return __hip_atomic_fetch_add(p, v, __ATOMIC_RELAXED, __HIP_MEMORY_SCOPE_AGENT); }
__device__ __forceinline__ unsigned xb_xcc_id() { return (unsigned)__builtin_amdgcn_s_getreg((3 << 11) | 20) & 0xFu; }
#define XB_SPIN(cond, bar) do { unsigned _sp = 0; while (cond) { __builtin_amdgcn_s_sleep(1); \
    if ((++_sp & 255u) == 0u) { if (xb_ld(&(bar)[XB_TMO])) break; if (_sp > XB_SPIN_CAP) { atomicAdd(&(bar)[XB_TMO], 1u); break; } } } } while (0)

struct XcdBarrier {
    unsigned* bar; unsigned x;
    volatile LAS unsigned* st;
};

__device__ __forceinline__ XcdBarrier xcd_barrier_post(unsigned* bar, volatile LAS unsigned* st) {
    XcdBarrier b; b.bar = bar; b.x = xb_xcc_id(); b.st = st;
    if (threadIdx.x == 0) (void)xb_add(&bar[XB_XCNT(b.x)], 1u);
    return b;
}
__device__ __forceinline__ void xcd_barrier_complete(unsigned* bar, unsigned x, unsigned& nloc, unsigned& nx) {
    const unsigned G = gridDim.x * gridDim.y * gridDim.z;
    unsigned sum, cnt, mine, sp = 0u;
    for (;;) {
        sum = 0u; cnt = 0u; mine = 0u;
#pragma unroll
        for (unsigned j = 0; j < 16; ++j) { const unsigned c = xb_ld(&bar[XB_XCNT(j)]); sum += c; cnt += (c > 0u) ? 1u : 0u; mine = (j == x) ? c : mine; }
        if (sum == G) break;
        __builtin_amdgcn_s_sleep(1);
        if ((++sp & 255u) == 0u) { if (xb_ld(&bar[XB_TMO])) break; if (sp > XB_SPIN_CAP) { atomicAdd(&bar[XB_TMO], 1u); break; } }
    }
    nloc = mine > 0u ? mine : 1u; nx = cnt > 0u ? cnt : 1u;
}

__device__ __forceinline__ void xcd_barrier(const XcdBarrier& b) {
    asm volatile("s_waitcnt vmcnt(0)" ::: "memory");
    __syncthreads();
    if (threadIdx.x == 0) {
        unsigned* bar = b.bar;
        __builtin_amdgcn_s_waitcnt(0);
        unsigned nloc = b.st[0], nx = b.st[1];
        if (nloc == 0u) { xcd_barrier_complete(bar, b.x, nloc, nx); b.st[0] = nloc; b.st[1] = nx; }
        const unsigned old = xb_add(&bar[XB_XSUB(b.x)], 1u);
        const unsigned gen = old / nloc;
        if (old + 1u == (gen + 1u) * nloc) {
            __builtin_amdgcn_fence(__ATOMIC_RELEASE, "agent");
            asm volatile("s_waitcnt vmcnt(0)" ::: "memory");
            const unsigned og = xb_add(&bar[XB_TOP], 1u);
            const unsigned tg = og / nx;
            if (og + 1u == (tg + 1u) * nx) xb_add(&bar[XB_TOPGEN], 1u);
            else XB_SPIN(xb_ld(&bar[XB_TOPGEN]) == tg, bar);
            __builtin_amdgcn_fence(__ATOMIC_ACQUIRE, "agent");
            xb_add(&bar[XB_XGEN(b.x)], 1u);
            asm volatile("s_waitcnt vmcnt(0)" ::: "memory");
        } else {
            XB_SPIN(xb_ld(&bar[XB_XGEN(b.x)]) == gen, bar);
            __builtin_amdgcn_fence(__ATOMIC_ACQUIRE, "agent");
            asm volatile("s_waitcnt vmcnt(0)" ::: "memory");
        }
    }
    __syncthreads();
}


struct TpItem { const float* W; const float* g; bf16_t* WT; int N, k0, n0, remap; };
DI TpItem tp_decode(int it, unsigned char* ws) {
    constexpr int T_IN = 16 * 65, T_SQ = 16 * 8; TpItem d;
    if (it < T_IN) { d.W = INP(3); d.g = INP(2); d.WT = (bf16_t*)(ws + WS_WTIN); d.N = 16416; d.k0 = (it / 65) * 128; d.n0 = (it % 65) * 256; d.remap = 1; return d; }
    int r = it - T_IN; const int which = r / T_SQ; r -= which * T_SQ;
    d.W = which == 0 ? INP(14) : which == 1 ? INP(15) : which == 2 ? INP(16) : INP(18); d.g = which == 3 ? INP(17) : nullptr;
    d.WT = (bf16_t*)(ws + (which == 0 ? WS_WTA : which == 1 ? WS_WTB : which == 2 ? WS_WTO : WS_WTQ)); d.N = 2048; d.k0 = (r / 8) * 128; d.n0 = (r % 8) * 256; d.remap = 0; return d;
}
DI void tp_load(const TpItem& d, f32x4 (&v)[16], int lane, int wave) {
    const bool inr = (d.n0 + lane * 4) < d.N;
#pragma unroll
    for (int i = 0; i < 16; ++i) { const int k = d.k0 + wave * 16 + i; v[i] = inr ? *(const f32x4*)(d.W + (size_t)k * d.N + d.n0 + lane * 4) : (f32x4){0.f, 0.f, 0.f, 0.f}; if (d.g) v[i] = v[i] * d.g[k]; }
}
DI void tp_pack(const f32x4 (&v)[16], LAS unsigned char* buf, int lane, int wave) {
#pragma unroll
    for (int e = 0; e < 4; ++e) { u32x4 lo, hi;
        lo.x = pk2(v[0][e], v[1][e]); lo.y = pk2(v[2][e], v[3][e]); lo.z = pk2(v[4][e], v[5][e]); lo.w = pk2(v[6][e], v[7][e]);
        hi.x = pk2(v[8][e], v[9][e]); hi.y = pk2(v[10][e], v[11][e]); hi.z = pk2(v[12][e], v[13][e]); hi.w = pk2(v[14][e], v[15][e]);
        LAS unsigned char* p = buf + (lane * 4 + e) * 272 + wave * 32; *(LAS u32x4*)p = lo; *(LAS u32x4*)(p + 16) = hi; }
}
DI void tp_store(const TpItem& d, const LAS unsigned char* buf, int tid) {
#pragma unroll
    for (int j = 0; j < 8; ++j) { const int c = tid + 512 * j, n = c >> 4, ch = c & 15; const int ns = d.n0 + n; if (ns >= d.N) continue;
        const int dr = d.remap ? (ns < 6144 ? ns : (ns < 6176 ? 16384 + (ns - 6144) : ns - 32)) : ns;
        *(u32x4*)(d.WT + (size_t)dr * 2048 + d.k0 + ch * 8) = *(const LAS u32x4*)(buf + n * 272 + ch * 16); }
}
DI void zero_chunks(unsigned char* base, int nchunks, int gt, int NT) { const u32x4 z = {0u, 0u, 0u, 0u}; for (int i = gt; i < nchunks; i += NT) *(u32x4*)(base + (size_t)i * 16) = z; }

DI void p0_prologue(LAS unsigned char* lds, int vcu, int G, int tid, int lane, int wave) {
    unsigned char* ws = WSB();
    const int gw = vcu * 8 + wave, NGW = G * 8, gt = vcu * 512 + tid, NT = G * 512;
    { constexpr int NT_ALL = 16 * 65 + 4 * 16 * 8; f32x4 tv[16]; int buf = 0;
      if (vcu < NT_ALL) { const TpItem d0 = tp_decode(vcu, ws); tp_load(d0, tv, lane, wave); }
      for (int it = vcu; it < NT_ALL; it += G) {
          const TpItem d = tp_decode(it, ws);
          tp_pack(tv, lds + buf * 69632, lane, wave);
          if (it + G < NT_ALL) { const TpItem dn = tp_decode(it + G, ws); tp_load(dn, tv, lane, wave); }
          __syncthreads();
          tp_store(d, lds + buf * 69632, tid);
          buf ^= 1; }
      __syncthreads(); }
    for (int m = gw; m < MROWS; m += NGW) {
        bf16_t* orow = (bf16_t*)(ws + WS_A) + (size_t)m * 2048;
        if (m >= TR + 16) { const u32x4 z = {0u, 0u, 0u, 0u};
#pragma unroll
            for (int j = 0; j < 4; ++j) ((u32x4*)orow)[lane + 64 * j] = z; continue; }
        const float* xr = m < TR ? INP(0) + (size_t)m * 2048 : INP(1) + (size_t)(m - TR) * 2048;
        f32x4 v[8]; float s = 0.f;
#pragma unroll
        for (int j = 0; j < 8; ++j) { v[j] = ((const f32x4*)xr)[lane + 64 * j]; s += (v[j].x * v[j].x + v[j].y * v[j].y) + (v[j].z * v[j].z + v[j].w * v[j].w); }
        const float rstd = rsqrtf(wave_sum(s) * (1.0f / 2048.0f) + EPSN);
#pragma unroll
        for (int j = 0; j < 8; ++j) { u32x2 o; o.x = pk2(v[j].x * rstd, v[j].y * rstd); o.y = pk2(v[j].z * rstd, v[j].w * rstd); ((u32x2*)orow)[lane + 64 * j] = o; }
    }
    { const float* keys = INP(19); bf16_t* kb = (bf16_t*)(ws + WS_KEYS);
      for (int i = gt; i < 32768; i += NT) { const f32x4 x0 = ((const f32x4*)keys)[2 * i], x1 = ((const f32x4*)keys)[2 * i + 1];
          u32x4 o; o.x = pk2(x0.x, x0.y); o.y = pk2(x0.z, x0.w); o.z = pk2(x1.x, x1.y); o.w = pk2(x1.z, x1.w); ((u32x4*)kb)[i] = o; } }
    { float* rope = (float*)(ws + WS_ROPE);
      for (int i = gt; i < LK * 16; i += NT) { const int pos = i >> 4, fi = i & 15;
          const double cs[16] = {0.15915494309189535, 0.0700865215877985, 0.03086376340470123, 0.013591370636193905, 0.005985185712713705, 0.002635675898667414, 0.001160663641240061, 0.0005111175045375439,
                                 0.00022507907903927653, 9.911730936901935e-05, 4.364795279280289e-05, 1.9221100684944863e-05, 8.464330808241401e-06, 3.727408601915352e-06, 1.6414262627950345e-06, 7.228293068832865e-07};
          double c = cs[0];
#pragma unroll
          for (int q = 1; q < 16; ++q) c = (fi == q) ? cs[q] : c;
          const double rev = (double)pos * c; const float fr = (float)(rev - __builtin_floor(rev));
          rope[2 * i] = __builtin_amdgcn_cosf(fr); rope[2 * i + 1] = __builtin_amdgcn_sinf(fr); } }
    for (int i = gt; i < TR; i += NT) ((float*)(ws + WS_SSQ))[i] = 0.f;
    for (int b = 0; b < NB; ++b) {
        zero_chunks(ws + WS_QG + (size_t)b * LKP * 1024 * 2, 64 * 1024 * 2 / 16, gt, NT);
        zero_chunks(ws + WS_KG + (size_t)b * LKP * 1024 * 2, 48 * 1024 * 2 / 16, gt, NT);
        { const u32x4 z = {0u, 0u, 0u, 0u}; for (int i = gt; i < 2048 * 6; i += NT) *(u32x4*)(ws + WS_VG + ((size_t)(b * 2048 + i / 6) * LKP) * 2 + (i % 6) * 16) = z; }
        zero_chunks(ws + WS_KD + ((size_t)b * LKP + LK) * 2048 * 2, 48 * 2048 * 2 / 16, gt, NT);
    }
    { const u32x4 z = {0u, 0u, 0u, 0u}; for (int i = gt; i < 8192 * 6; i += NT) { const int row = i / 6, c = i % 6; *(u32x4*)(ws + WS_VDT + (size_t)row * (LKP * 2) + LK * 2 + c * 16) = z; } }
}

DI int permpos(int pos) { return (pos & ~31) | ((pos & 12) << 1) | ((pos & 16) >> 2) | (pos & 3); }
DI void st4bf(bf16_t* p, f32x4 v) { u32x2 o; o.x = pk2(v.x, v.y); o.y = pk2(v.z, v.w); *(u32x2*)p = o; }
struct EpiIn {
    static constexpr bool PERM = false, AFTER_DRAIN = false;
    bf16_t *Qg, *Kg, *Vg, *R, *Qd, *Kd, *VdT, *SA, *SB; const float* rope;
    __device__ __forceinline__ void operator()(const f32x4 (&acc)[2][2][4][2], const pg8::Unit& u, int wr, int wc, int fr, int fq) const {
        const int pn = u.pn, pm = u.pm;
        int sec, cb;
        if (pn < 4) { sec = 0; cb = pn * 256; } else if (pn < 8) { sec = 1; cb = (pn - 4) * 256; } else if (pn < 16) { sec = 2; cb = (pn - 8) * 256; } else if (pn < 24) { sec = 3; cb = (pn - 16) * 256; }
        else if (pn < 32) { sec = 4; cb = (pn - 24) * 256; } else if (pn < 40) { sec = 5; cb = (pn - 32) * 256; } else if (pn < 48) { sec = 6; cb = (pn - 40) * 256; } else if (pn < 56) { sec = 7; cb = (pn - 48) * 256; }
        else { sec = 8; cb = (pn - 56) * 256; }
#pragma unroll
        for (int ai = 0; ai < 2; ++ai)
#pragma unroll
            for (int m = 0; m < 4; ++m) {
                const int r = pm * 256 + ai * 128 + wr * 64 + m * 16 + fr, b = r >> 11, s = r & 2047;
                const int pos = 16 + s;
                const int pg = 64 + s;
#pragma unroll
                for (int bj = 0; bj < 2; ++bj) {
                    const int c0 = cb + bj * 128 + wc * 32 + 4 * fq;
                    f32x4 v0 = acc[ai][bj][m][0], v1 = acc[ai][bj][m][1];
                    if ((sec == 4 || sec == 5) && wc == 0) {
                        const f32x4 t0 = *(const f32x4*)(rope + (pos * 16 + 4 * fq) * 2), t1 = *(const f32x4*)(rope + (pos * 16 + 4 * fq) * 2 + 4);
                        const f32x4 cc = {t0.x, t0.z, t1.x, t1.z}, sn = {t0.y, t0.w, t1.y, t1.w};
                        const f32x4 a1 = v0 * cc - v1 * sn, a2 = v0 * sn + v1 * cc; v0 = a1; v1 = a2;
                    }
                    if (sec == 0) { bf16_t* d = Qg + (size_t)(b * LKP + pg) * 1024 + c0; st4bf(d, v0 * 0.0625f); st4bf(d + 16, v1 * 0.0625f); }
                    else if (sec == 1) { bf16_t* d = Kg + (size_t)(b * LKP + pg) * 1024 + c0; st4bf(d, v0); st4bf(d + 16, v1); }
                    else if (sec == 2) { bf16_t* d = Vg + (size_t)(b * 2048 + c0) * LKP + pg;
#pragma unroll
                        for (int e = 0; e < 4; ++e) { d[(size_t)e * LKP] = f2bf(v0[e]); d[(size_t)(16 + e) * LKP] = f2bf(v1[e]); } }
                    else if (sec == 3) { bf16_t* d = R + (size_t)r * 2048 + c0; f32x4 g0, g1;
#pragma unroll
                        for (int e = 0; e < 4; ++e) { g0[e] = v0[e] * sigmoidf_(v0[e]); g1[e] = v1[e] * sigmoidf_(v1[e]); }
                        st4bf(d, g0); st4bf(d + 16, g1); }
                    else if (sec == 4) { bf16_t* d = Qd + (size_t)r * 2048 + c0; st4bf(d, v0 * C2Q); st4bf(d + 16, v1 * C2Q); }
                    else if (sec == 5) { bf16_t* d = Kd + (size_t)(b * LKP + pos) * 2048 + c0; st4bf(d, v0); st4bf(d + 16, v1); }
                    else if (sec == 6) { const int head = c0 >> 8, dv0 = c0 & 255, pp = permpos(pos); bf16_t* d = VdT + (size_t)((b * 8 + head) * 256 + dv0) * LKP + pp;
#pragma unroll
                        for (int e = 0; e < 4; ++e) { d[(size_t)e * LKP] = f2bf(v0[e]); d[(size_t)(16 + e) * LKP] = f2bf(v1[e]); } }
                    else { bf16_t* d = SA + (size_t)(sec - 7) * ((WS_SB - WS_SA) / 2) + (size_t)r * 2048 + c0; f32x4 g0, g1;
#pragma unroll
                        for (int e = 0; e < 4; ++e) { g0[e] = sigmoidf_(v0[e]); g1[e] = sigmoidf_(v1[e]); }
                        st4bf(d, g0); st4bf(d + 16, g1); }
                }
            }
    }
};
DI void side_gemm(unsigned char* ws, int vcu, int G, int lane, int wave) {
    const bf16_t* A = (const bf16_t*)(ws + WS_A); const bf16_t* Bt = (const bf16_t*)(ws + WS_WTIN); const float* rope = (const float*)(ws + WS_ROPE);
    bf16_t* Kg = (bf16_t*)(ws + WS_KG); bf16_t* Vg = (bf16_t*)(ws + WS_VG); bf16_t* Kd = (bf16_t*)(ws + WS_KD); bf16_t* VdT = (bf16_t*)(ws + WS_VDT); float* LR = (float*)(ws + WS_LR);
    const int fr = lane & 15, g4 = lane >> 4;
    for (int it = wave * G + vcu; it < 737; it += G * 8) {
        int row0, col0;
        if (it < 513) { row0 = it * 16; col0 = 16384; }
        else { const int q = it - 513; row0 = 8192; col0 = q < 32 ? 1024 + q * 32 : q < 96 ? 2048 + (q - 32) * 32 : q < 160 ? 8192 + (q - 96) * 32 : 10240 + (q - 160) * 32; }
        const bf16_t* ap = A + (size_t)(row0 + fr) * 2048 + 8 * g4; const bf16_t* bp0 = Bt + (size_t)(col0 + fr) * 2048 + 8 * g4; const bf16_t* bp1 = bp0 + (size_t)16 * 2048;
        f32x4 acc0 = {0.f, 0.f, 0.f, 0.f}, acc1 = {0.f, 0.f, 0.f, 0.f};
#pragma unroll 8
        for (int ks = 0; ks < 64; ++ks) { const bf16x8 av = *(const bf16x8*)(ap + ks * 32), b0 = *(const bf16x8*)(bp0 + ks * 32), b1 = *(const bf16x8*)(bp1 + ks * 32); acc0 = MFMA16(av, b0, acc0); acc1 = MFMA16(av, b1, acc1); }
#pragma unroll
        for (int rg = 0; rg < 4; ++rg) { const int rl = 4 * g4 + rg; float x0 = acc0[rg], x1 = acc1[rg];
            if (it < 512) { const int r = row0 + rl, b = r >> 11, s = r & 2047; float* d = LR + (size_t)(b * LKP + 64 + s) * 32 + fr; d[0] = x0; d[16] = x1; }
            else if (it == 512) { for (int bb = 0; bb < NB; ++bb) { float* d = LR + (size_t)(bb * LKP + 48 + rl) * 32 + fr; d[0] = x0; d[16] = x1; } }
            else if (col0 < 2048) { for (int bb = 0; bb < NB; ++bb) { bf16_t* d = Kg + (size_t)(bb * LKP + 48 + rl) * 1024 + (col0 - 1024) + fr; d[0] = f2bf(x0); d[16] = f2bf(x1); } }
            else if (col0 < 4096) { for (int bb = 0; bb < NB; ++bb) { bf16_t* d = Vg + (size_t)(bb * 2048 + (col0 - 2048) + fr) * LKP + 48 + rl; d[0] = f2bf(x0); d[(size_t)16 * LKP] = f2bf(x1); } }
            else if (col0 < 10240) { const int cs = col0 - 8192;
                if ((cs & 127) == 0) { const float c = rope[(rl * 16 + fr) * 2], sn = rope[(rl * 16 + fr) * 2 + 1]; const float a1 = x0 * c - x1 * sn, a2 = x0 * sn + x1 * c; x0 = a1; x1 = a2; }
                for (int bb = 0; bb < NB; ++bb) { bf16_t* d = Kd + (size_t)(bb * LKP + rl) * 2048 + cs + fr; d[0] = f2bf(x0); d[16] = f2bf(x1); } }
            else { const int cs = col0 - 10240, head = cs >> 8, dv = (cs & 255) + fr, pp = permpos(rl);
                for (int bb = 0; bb < NB; ++bb) { bf16_t* d = VdT + (size_t)((bb * 8 + head) * 256 + dv) * LKP + pp; d[0] = f2bf(x0); d[(size_t)16 * LKP] = f2bf(x1); } }
        }
    }
}

DI float logsig(float z) { return -(fmaxf(-z, 0.f) + __logf(1.0f + __expf(-fabsf(z)))); }
DI void gla_prep(LAS unsigned char* lds, int vcu, int G, int tid, int lane, int wave) {
    unsigned char* ws = WSB();
    LAS float* lrS = (LAS float*)lds;
    LAS bf16_t* qS = (LAS bf16_t*)(lds + 8192); LAS bf16_t* kS = (LAS bf16_t*)(lds + 8192 + 33792); LAS bf16_t* kstS = (LAS bf16_t*)(lds + 8192 + 2 * 33792);
    const bf16_t* Qg = (const bf16_t*)(ws + WS_QG); const bf16_t* Kg = (const bf16_t*)(ws + WS_KG); const float* LR = (const float*)(ws + WS_LR);
    bf16_t* QIN = (bf16_t*)(ws + WS_QIN); bf16_t* KST = (bf16_t*)(ws + WS_KST); bf16_t* AMAT = (bf16_t*)(ws + WS_AMAT); float* DEC = (float*)(ws + WS_DEC);
    const int fr = lane & 15, g4 = lane >> 4;
    for (int u = vcu; u < 1056; u += G) {
        const int dir = u / 528, rem = u % 528, bh = rem / 33, step = rem % 33;
        if (dir == 1 && step == 32) continue;
        const int b = bh >> 2, h = bh & 3, c = dir ? 32 - step : step, slot = (dir * 16 + bh) * 33 + step;
        const float* w2 = dir ? INP(6) : INP(4); const float* bia = dir ? INP(7) : INP(5);
        __syncthreads();
        if (tid < 256) { const int row = tid >> 2, q4 = tid & 3, p = dir ? 64 * c + 63 - row : 64 * c + row;
            *(LAS f32x4*)(lrS + row * 16 + 4 * q4) = *(const f32x4*)(LR + (size_t)(b * LKP + p) * 32 + dir * 16 + 4 * q4); }
#pragma unroll
        for (int i = 0; i < 4; ++i) { const int ck = tid + 512 * i, row = ck >> 5, cc = ck & 31, p = dir ? 64 * c + 63 - row : 64 * c + row;
            *(LAS u32x4*)((LAS unsigned char*)qS + row * 528 + cc * 16) = *(const u32x4*)(Qg + (size_t)(b * LKP + p) * 1024 + h * 256 + cc * 8);
            *(LAS u32x4*)((LAS unsigned char*)kS + row * 528 + cc * 16) = *(const u32x4*)(Kg + (size_t)(b * LKP + p) * 1024 + h * 256 + cc * 8); }
        float wb[2][4], bsv[2];
#pragma unroll
        for (int db = 0; db < 2; ++db) { const int d = h * 256 + (wave * 2 + db) * 16 + fr; bsv[db] = bia[d];
#pragma unroll
            for (int ks = 0; ks < 4; ++ks) wb[db][ks] = w2[(4 * ks + g4) * 1024 + d]; }
        __syncthreads();
        f32x4 lf[4][2];
#pragma unroll
        for (int tb = 0; tb < 4; ++tb) { float la[4];
#pragma unroll
            for (int ks = 0; ks < 4; ++ks) la[ks] = lrS[(tb * 16 + fr) * 16 + 4 * ks + g4];
#pragma unroll
            for (int db = 0; db < 2; ++db) { f32x4 z = {0.f, 0.f, 0.f, 0.f};
#pragma unroll
                for (int ks = 0; ks < 4; ++ks) z = __builtin_amdgcn_mfma_f32_16x16x4f32(la[ks], wb[db][ks], z, 0, 0, 0);
#pragma unroll
                for (int rg = 0; rg < 4; ++rg) { const int tau = tb * 16 + 4 * g4 + rg, p = dir ? 64 * c + 63 - tau : 64 * c + tau; z[rg] = (p < 48) ? 0.f : logsig(z[rg] + bsv[db]) * 0.0625f; }
                lf[tb][db] = z; } }
        float blast[2];
#pragma unroll
        for (int db = 0; db < 2; ++db) { float base = 0.f;
#pragma unroll
            for (int tb = 0; tb < 4; ++tb) { f32x4 v = lf[tb][db]; v[1] += v[0]; v[2] += v[1]; v[3] += v[2];
                const float t = v[3]; const float t0 = __shfl(t, fr), t1 = __shfl(t, fr + 16), t2 = __shfl(t, fr + 32), t3 = __shfl(t, fr + 48);
                const float off = base + (g4 > 0 ? t0 : 0.f) + (g4 > 1 ? t1 : 0.f) + (g4 > 2 ? t2 : 0.f);
                lf[tb][db] = v + off; base += (t0 + t1) + (t2 + t3); }
            blast[db] = base; }
#pragma unroll
        for (int db = 0; db < 2; ++db) { const int d = (wave * 2 + db) * 16 + fr;
#pragma unroll
            for (int tb = 0; tb < 4; ++tb) { unsigned kw[2];
#pragma unroll
                for (int rg = 0; rg < 4; ++rg) { const int tau = tb * 16 + 4 * g4 + rg; const float bc = lf[tb][db][rg];
                    const float qv = bf2f(qS[tau * 264 + d]), kv = bf2f(kS[tau * 264 + d]);
                    const float qi = qv * __expf(bc), ki = kv * __expf(-bc), ks = kv * __expf(blast[db] - bc);
                    qS[tau * 264 + d] = f2bf(qi); kS[tau * 264 + d] = f2bf(ki);
                    if (rg & 1) kw[rg >> 1] |= ((unsigned)f2bf(ks)) << 16; else kw[rg >> 1] = (unsigned)f2bf(ks); }
                if (dir) *(LAS u32x2*)((LAS unsigned char*)kstS + d * 144 + (60 - tb * 16 - 4 * g4) * 2) = (u32x2){(kw[1] >> 16) | (kw[1] << 16), (kw[0] >> 16) | (kw[0] << 16)};
                else *(LAS u32x2*)((LAS unsigned char*)kstS + d * 144 + (tb * 16 + 4 * g4) * 2) = (u32x2){kw[0], kw[1]}; }
            if (g4 == 0) DEC[slot * 256 + d] = __expf(blast[db]); }
        __syncthreads();
#pragma unroll
        for (int i = 0; i < 4; ++i) { const int ck = tid + 512 * i; *(u32x4*)(KST + (size_t)slot * 16384 + (ck >> 3) * 64 + (ck & 7) * 8) = *(const LAS u32x4*)((const LAS unsigned char*)kstS + (ck >> 3) * 144 + (ck & 7) * 16);
            *(u32x4*)(QIN + (size_t)slot * 16384 + (ck >> 5) * 256 + (ck & 31) * 8) = *(const LAS u32x4*)((const LAS unsigned char*)qS + (ck >> 5) * 528 + (ck & 31) * 16); }
#pragma unroll
        for (int q = 0; q < 2; ++q) { const int bl = wave * 2 + q, tb = bl >> 2, sb = bl & 3; f32x4 acc = {0.f, 0.f, 0.f, 0.f};
#pragma unroll
            for (int ks = 0; ks < 8; ++ks) { const bf16x8 av = *(const LAS bf16x8*)(qS + (tb * 16 + fr) * 264 + ks * 32 + 8 * g4), bv8 = *(const LAS bf16x8*)(kS + (sb * 16 + fr) * 264 + ks * 32 + 8 * g4);
                acc = MFMA16(av, bv8, acc); }
#pragma unroll
            for (int rg = 0; rg < 4; ++rg) { const int tau = tb * 16 + 4 * g4 + rg, sig = sb * 16 + fr; const bool keep = dir ? (sig < tau) : (sig <= tau);
                AMAT[(size_t)slot * 4096 + tau * 64 + (dir ? 63 - sig : sig)] = f2bf(keep ? acc[rg] : 0.f); } }
    }
}

constexpr int SC_QS = 0, SC_KT = 33792, SC_AS = 70656, SC_VT = 79872, SC_DEC = 89088, SC_OS = 90112;
DI void gla_scan(LAS unsigned char* lds, int vcu, int G, int tid, int lane, int wave) {
    unsigned char* ws = WSB();
    const bf16_t* QIN = (const bf16_t*)(ws + WS_QIN); const bf16_t* KST = (const bf16_t*)(ws + WS_KST); const bf16_t* AMAT = (const bf16_t*)(ws + WS_AMAT);
    const float* DEC = (const float*)(ws + WS_DEC); const bf16_t* Vg = (const bf16_t*)(ws + WS_VG);
    const int fr = lane & 15, g4 = lane >> 4, dvg = wave & 3, dkh = wave >> 2;
    LAS float* oS = (LAS float*)(lds + SC_OS);
    const float* cvU = INP(20); const float* cvV = INP(21); const float* cvG = INP(17);
    for (int u = vcu; u < 256; u += G) {
        const int dir = u >> 7, bh = (u >> 3) & 15, sl = u & 7, b = bh >> 2, h = bh & 3, nsteps = dir ? 32 : 33;
        bf16_t* Od = (bf16_t*)(ws + (dir ? WS_OB : WS_OF));
        f32x4 St[8];
#pragma unroll
        for (int i = 0; i < 8; ++i) St[i] = (f32x4){0.f, 0.f, 0.f, 0.f};
        u32x4 rq[4], rk[4], ra, rv; f32x4 rd = {0.f, 0.f, 0.f, 0.f};
        { const int slot = (dir * 16 + bh) * 33, c = dir ? 32 : 0; const int tau = tid >> 3, p = dir ? 64 * c + 63 - tau : 64 * c + tau;
#pragma unroll
          for (int i = 0; i < 4; ++i) { rq[i] = ((const u32x4*)(QIN + (size_t)slot * 16384))[tid + 512 * i]; rk[i] = ((const u32x4*)(KST + (size_t)slot * 16384))[tid + 512 * i]; }
          ra = ((const u32x4*)(AMAT + (size_t)slot * 4096))[tid]; rv = *(const u32x4*)(Vg + (size_t)(b * 2048 + h * 512 + sl * 64 + (tid >> 3)) * LKP + 64 * c + (tid & 7) * 8);
          if (tid < 64) rd = ((const f32x4*)(DEC + slot * 256))[tid]; }
        for (int step = 0; step < nsteps; ++step) {
            const int c = dir ? 32 - step : step;
#pragma unroll
            for (int i = 0; i < 4; ++i) { const int cq = tid + 512 * i; *(LAS u32x4*)(lds + SC_QS + (cq >> 5) * 528 + (cq & 31) * 16) = rq[i]; *(LAS u32x4*)(lds + SC_KT + (cq >> 3) * 144 + (cq & 7) * 16) = rk[i]; }
            *(LAS u32x4*)(lds + SC_AS + (tid >> 3) * 144 + (tid & 7) * 16) = ra;
            *(LAS u32x4*)(lds + SC_VT + (tid >> 3) * 144 + (tid & 7) * 16) = rv;
            if (tid < 64) *(LAS f32x4*)(lds + SC_DEC + tid * 16) = rd;
            __syncthreads();
            if (step + 1 < nsteps) { const int slot = (dir * 16 + bh) * 33 + step + 1, cn = dir ? 31 - step : step + 1; const int tau = tid >> 3, p = dir ? 64 * cn + 63 - tau : 64 * cn + tau;
#pragma unroll
                for (int i = 0; i < 4; ++i) { rq[i] = ((const u32x4*)(QIN + (size_t)slot * 16384))[tid + 512 * i]; rk[i] = ((const u32x4*)(KST + (size_t)slot * 16384))[tid + 512 * i]; }
                ra = ((const u32x4*)(AMAT + (size_t)slot * 4096))[tid]; rv = *(const u32x4*)(Vg + (size_t)(b * 2048 + h * 512 + sl * 64 + (tid >> 3)) * LKP + 64 * cn + (tid & 7) * 8);
                if (tid < 64) rd = ((const f32x4*)(DEC + slot * 256))[tid]; }
            f32x4 cvv[4]; const int cidx = step * 2048 + (vcu * 8 + wave); const bool cv_on = (G == 256) && cidx < 65536; const int ctab = cidx >> 15, cci = cidx & 32767;
            if (cv_on) { const f32x4* src = (const f32x4*)(ctab ? cvV : cvU) + (size_t)cci * 256 + lane;
#pragma unroll
                for (int q = 0; q < 4; ++q) cvv[q] = src[q * 64]; }
            const bool has_out = (c != 0);
            bf16x8 vb[2];
#pragma unroll
            for (int ks = 0; ks < 2; ++ks) vb[ks] = *(const LAS bf16x8*)(lds + SC_VT + (dvg * 16 + fr) * 144 + (ks * 32 + 8 * g4) * 2);
            if (has_out) {
                f32x4 ao[4];
#pragma unroll
                for (int tb = 0; tb < 4; ++tb) ao[tb] = (f32x4){0.f, 0.f, 0.f, 0.f};
#pragma unroll
                for (int ks = 0; ks < 4; ++ks) {
                    u32x4 bw; bw.x = pk2(St[2 * ks][0], St[2 * ks][1]); bw.y = pk2(St[2 * ks][2], St[2 * ks][3]); bw.z = pk2(St[2 * ks + 1][0], St[2 * ks + 1][1]); bw.w = pk2(St[2 * ks + 1][2], St[2 * ks + 1][3]);
                    const bf16x8 bs = __builtin_bit_cast(bf16x8, bw);
#pragma unroll
                    for (int tb = 0; tb < 4; ++tb) {
                        const LAS unsigned char* qp = lds + SC_QS + (tb * 16 + fr) * 528 + (dkh * 128 + ks * 32 + 4 * g4) * 2;
                        const u32x2 lo = *(const LAS u32x2*)qp, hi = *(const LAS u32x2*)(qp + 32);
                        const u32x4 aw = {lo.x, lo.y, hi.x, hi.y};
                        ao[tb] = MFMA16(__builtin_bit_cast(bf16x8, aw), bs, ao[tb]); }
                }
#pragma unroll
                for (int tb = 0; tb < 4; ++tb) if ((tb >> 1) == dkh) {
#pragma unroll
                    for (int ks = 0; ks < 2; ++ks) { const bf16x8 av = *(const LAS bf16x8*)(lds + SC_AS + (tb * 16 + fr) * 144 + (ks * 32 + 8 * g4) * 2); ao[tb] = MFMA16(av, vb[ks], ao[tb]); } }
#pragma unroll
                for (int tb = 0; tb < 4; ++tb)
#pragma unroll
                    for (int rg = 0; rg < 4; ++rg) oS[wave * 1024 + (tb * 16 + 4 * g4 + rg) * 16 + fr] = ao[tb][rg];
            }
#pragma unroll
            for (int kb = 0; kb < 8; ++kb) { const f32x4 dc = *(const LAS f32x4*)(lds + SC_DEC + (dkh * 128 + kb * 16 + 4 * g4) * 4); St[kb] = St[kb] * dc;
#pragma unroll
                for (int ks = 0; ks < 2; ++ks) { const bf16x8 av = *(const LAS bf16x8*)(lds + SC_KT + (dkh * 128 + kb * 16 + fr) * 144 + (ks * 32 + 8 * g4) * 2); St[kb] = MFMA16(av, vb[ks], St[kb]); } }
            __syncthreads();
            if (has_out) { const int tau = tid >> 3, c8 = tid & 7, dg = c8 >> 1, o8 = (c8 & 1) * 8; const int p = dir ? 64 * c + 63 - tau : 64 * c + tau, s = p - 64;
                const LAS float* p0 = oS + dg * 1024 + tau * 16 + o8; const LAS float* p1 = oS + (4 + dg) * 1024 + tau * 16 + o8;
                const f32x4 x0 = *(const LAS f32x4*)p0 + *(const LAS f32x4*)p1, x1 = *(const LAS f32x4*)(p0 + 4) + *(const LAS f32x4*)(p1 + 4);
                u32x4 o; o.x = pk2(x0.x, x0.y); o.y = pk2(x0.z, x0.w); o.z = pk2(x1.x, x1.y); o.w = pk2(x1.z, x1.w);
                *(u32x4*)(Od + (size_t)(b * SEQ + s) * 2048 + h * 512 + sl * 64 + c8 * 8) = o; }
            if (cv_on) { unsigned* dst = (unsigned*)(ws + (ctab ? WS_V : WS_U)) + (size_t)cci * 256 + lane;
#pragma unroll
                for (int q = 0; q < 4; ++q) { f32x4 x = cvv[q];
                    if (ctab) x = x * 64.0f; else x = x * (*(const f32x4*)(cvG + (cci & 1) * 1024 + q * 256 + lane * 4) * 1024.0f);
                    int w = __builtin_amdgcn_cvt_pk_fp8_f32(x.x, x.y, 0, false); w = __builtin_amdgcn_cvt_pk_fp8_f32(x.z, x.w, w, true); dst[q * 64] = (unsigned)w; } }
        }
        __syncthreads();
    }
}

constexpr int AT_K0 = 0, AT_KSZ = 34816, AT_V0 = 2 * 34816, AT_VSZ = 32768, AT_O2 = 0;
DI void attn_phase(LAS unsigned char* lds, int vcu, int G, int tid, int lane, int wave) {
    unsigned char* ws = WSB();
    const bf16_t* Qd = (const bf16_t*)(ws + WS_QD); bf16_t* Od = (bf16_t*)(ws + WS_OD); const bf16_t* Kd = (const bf16_t*)(ws + WS_KD); const bf16_t* VdT = (const bf16_t*)(ws + WS_VDT);
    const int fr = lane & 15, g4 = lane >> 4, map = wave >> 2, qs = wave & 3;
    const bool grpA = (map == 0);
    float lam;
    { float s1 = 0.f, s2 = 0.f; const float* l1 = INP(9); const float* l2 = INP(10); const float* l3 = INP(11); const float* l4 = INP(12);
      for (int i = 0; i < 128; ++i) { s1 += l1[i] * l2[i]; s2 += l3[i] * l4[i]; } lam = __expf(s1) - __expf(s2) + 0.2f; }
    const float* gno = INP(13);
    const unsigned koff = (unsigned)(tid >> 5) * 4096u + (unsigned)(tid & 31) * 16u, voff = (unsigned)(tid >> 3) * (unsigned)(LKP * 2) + (unsigned)(tid & 7) * 16u;
    const unsigned kdst = AT_K0 + (((tid & 31) >> 4) * 64 + (tid >> 5)) * 272 + (tid & 15) * 16, vdst = AT_V0 + (tid >> 3) * 128 + (((tid & 7) ^ ((tid >> 4) & 7)) * 16);
    const unsigned krd = AT_K0 + (map * 64 + fr) * 272 + g4 * 16;
    const unsigned vrd0 = AT_V0 + fr * 128 + ((g4 ^ ((fr >> 1) & 7)) * 16), vrd1 = AT_V0 + fr * 128 + (((4 + g4) ^ ((fr >> 1) & 7)) * 16);
    for (int u = vcu; u < 1024; u += G) {
        const int bh = u >> 5, qb = u & 31, b = bh >> 3, h = bh & 7, q0 = b * SEQ + qb * 64;
        bf16x8 qf[4];
#pragma unroll
        for (int ks = 0; ks < 4; ++ks) qf[ks] = *(const bf16x8*)(Qd + (size_t)(q0 + qs * 16 + fr) * 2048 + h * 256 + map * 128 + ks * 32 + 8 * g4);
        f32x4 oacc[16];
#pragma unroll
        for (int i = 0; i < 16; ++i) oacc[i] = (f32x4){0.f, 0.f, 0.f, 0.f};
        float mrun = 0.f, lrun = 0.f, mxp = -1e30f;
        u32x4 rk[4], rv[4]; bf16x8 bp[2]; f32x4 sacc[4];
        const unsigned char* kbase = (const unsigned char*)(Kd + (size_t)b * LKP * 2048 + h * 256);
        const unsigned char* vbase = (const unsigned char*)(VdT + (size_t)((b * 8 + h) * 256) * LKP);
#define AT_LOADK(tt) do { const unsigned char* kt_ = kbase + (size_t)((tt) * 64) * 4096; _Pragma("unroll") for (int i = 0; i < 4; ++i) rk[i] = *(const u32x4*)(kt_ + (size_t)(16 * i) * 4096 + koff); } while (0)
#define AT_LOADV(tt) do { const unsigned char* vt_ = vbase + (tt) * 128; _Pragma("unroll") for (int i = 0; i < 4; ++i) rv[i] = *(const u32x4*)(vt_ + (size_t)(64 * i) * (LKP * 2) + voff); } while (0)
#define AT_WRITEK(tt) do { const unsigned o_ = (unsigned)((tt) & 1) * AT_KSZ; _Pragma("unroll") for (int i = 0; i < 4; ++i) *(LAS u32x4*)(lds + o_ + kdst + i * (16 * 272)) = rk[i]; } while (0)
#define AT_WRITEV(tt) do { const unsigned o_ = (unsigned)((tt) & 1) * AT_VSZ; _Pragma("unroll") for (int i = 0; i < 4; ++i) *(LAS u32x4*)(lds + o_ + vdst + i * (64 * 128)) = rv[i]; } while (0)
#define AT_S_SM(tt) do { const unsigned ko_ = (unsigned)((tt) & 1) * AT_KSZ; \
            _Pragma("unroll") for (int kb = 0; kb < 4; ++kb) { sacc[kb] = (f32x4){0.f, 0.f, 0.f, 0.f}; \
                _Pragma("unroll") for (int ks = 0; ks < 4; ++ks) { const bf16x8 av = *(const LAS bf16x8*)(lds + ko_ + krd + kb * (16 * 272) + ks * 64); sacc[kb] = MFMA16(av, qf[ks], sacc[kb]); } } \
            __builtin_amdgcn_sched_barrier(0); \
            if ((tt) == 32) { sacc[1] = (f32x4){-1e30f, -1e30f, -1e30f, -1e30f}; sacc[2] = sacc[1]; sacc[3] = sacc[1]; } \
            mxp = -1e30f;        \
            _Pragma("unroll") for (int kb = 0; kb < 4; ++kb) mxp = fmaxf(fmaxf(mxp, fmaxf(sacc[kb][0], sacc[kb][1])), fmaxf(sacc[kb][2], sacc[kb][3])); \
            if ((tt) == 0) { float m0_ = fmaxf(mxp, __shfl_xor(mxp, 16)); mrun = fmaxf(m0_, __shfl_xor(m0_, 32)); }        \
            float rs = 0.f; \
            _Pragma("unroll") for (int kb = 0; kb < 4; ++kb) _Pragma("unroll") for (int j = 0; j < 4; ++j) { const float p = __builtin_amdgcn_exp2f(sacc[kb][j] - mrun); sacc[kb][j] = p; rs += p; } \
            lrun += rs; \
            _Pragma("unroll") for (int s2 = 0; s2 < 2; ++s2) { u32x4 pw; pw.x = pk2(sacc[2 * s2][0], sacc[2 * s2][1]); pw.y = pk2(sacc[2 * s2][2], sacc[2 * s2][3]); pw.z = pk2(sacc[2 * s2 + 1][0], sacc[2 * s2 + 1][1]); pw.w = pk2(sacc[2 * s2 + 1][2], sacc[2 * s2 + 1][3]); \
                bp[s2] = __builtin_bit_cast(bf16x8, pw); } \
            __builtin_amdgcn_sched_barrier(0); } while (0)
#define AT_PV(tt) do { const unsigned vo_ = (unsigned)((tt) & 1) * AT_VSZ; \
            _Pragma("unroll") for (int dq = 0; dq < 4; ++dq) { \
                _Pragma("unroll") for (int d4 = 0; d4 < 4; ++d4) { const int dvb = dq * 4 + d4; \
                    const bf16x8 a0 = *(const LAS bf16x8*)(lds + vo_ + vrd0 + dvb * 2048), a1 = *(const LAS bf16x8*)(lds + vo_ + vrd1 + dvb * 2048); \
                    oacc[dvb] = MFMA16(a0, bp[0], oacc[dvb]); oacc[dvb] = MFMA16(a1, bp[1], oacc[dvb]); } \
                __builtin_amdgcn_sched_barrier(0); } \
            { float mx = fmaxf(mxp, __shfl_xor(mxp, 16)); mx = fmaxf(mx, __shfl_xor(mx, 32));        \
              if (!__all(mx <= mrun + 4.0f)) { const float mnew = fmaxf(mrun, mx), alpha = __builtin_amdgcn_exp2f(mrun - mnew); mrun = mnew; lrun *= alpha; \
                  _Pragma("unroll") for (int i = 0; i < 16; ++i) oacc[i] = oacc[i] * alpha; } } } while (0)
        AT_LOADK(0); AT_LOADV(0);
        AT_WRITEK(0); AT_WRITEV(0);
        AT_LOADK(1); AT_LOADV(1);
        __syncthreads();
        for (int t = 0; t < 33; ++t) {
            if (grpA) { AT_S_SM(t); } else if (t > 0) { AT_PV(t - 1); }
            if (t + 1 < 33) AT_WRITEK(t + 1);
            if (t + 2 < 33) AT_LOADK(t + 2);
            __syncthreads();
            if (grpA) { AT_PV(t); } else { AT_S_SM(t); }
            if (t + 1 < 33) AT_WRITEV(t + 1);
            if (t + 2 < 33) AT_LOADV(t + 2);
            __syncthreads();
        }
        if (!grpA) { AT_PV(32); }
        __syncthreads();
#undef AT_LOADK
#undef AT_LOADV
#undef AT_WRITEK
#undef AT_WRITEV
#undef AT_S_SM
#undef AT_PV
        lrun += __shfl_xor(lrun, 16); lrun += __shfl_xor(lrun, 32);
        const float inv = 1.0f / lrun;
        LAS float* o2 = (LAS float*)(lds + AT_O2);
        const int q = qs * 16 + fr;
        if (map == 1) {
#pragma unroll
            for (int dvb = 0; dvb < 16; ++dvb) *(LAS f32x4*)(o2 + q * 260 + dvb * 16 + 4 * g4) = oacc[dvb] * inv;
        }
        __syncthreads();
        if (map == 0) {
            float ss = 0.f;
#pragma unroll
            for (int dvb = 0; dvb < 16; ++dvb) { const f32x4 v2 = *(const LAS f32x4*)(o2 + q * 260 + dvb * 16 + 4 * g4); const f32x4 o = oacc[dvb] * inv - v2 * lam; oacc[dvb] = o; ss += (o.x * o.x + o.y * o.y) + (o.z * o.z + o.w * o.w); }
            ss += __shfl_xor(ss, 16); ss += __shfl_xor(ss, 32);
            const float rstd = rsqrtf(ss * (1.0f / 256.0f) + EPSN) * 0.8f;
#pragma unroll
            for (int dvb = 0; dvb < 16; ++dvb) { const int dv0 = dvb * 16 + 4 * g4; const f32x4 g = *(const f32x4*)(gno + dv0); st4bf(Od + (size_t)(q0 + q) * 2048 + h * 256 + dv0, oacc[dvb] * g * rstd); }
        }
        __syncthreads();
    }
}

DI void gla_post(int vcu, int G, int lane, int wave) {
    unsigned char* ws = WSB(); const bf16_t* OF = (const bf16_t*)(ws + WS_OF); const bf16_t* OB = (const bf16_t*)(ws + WS_OB); const bf16_t* R = (const bf16_t*)(ws + WS_R); bf16_t* OG = (bf16_t*)(ws + WS_OG);
    const float* g = INP(8);
    const f32x4 g0 = *(const f32x4*)(g + lane * 8), g1 = *(const f32x4*)(g + lane * 8 + 4);
    for (int it = vcu * 8 + wave; it < TR * 4; it += G * 8) {
        const size_t off = (size_t)(it >> 2) * 2048 + (it & 3) * 512 + lane * 8;
        const u32x4 f = *(const u32x4*)(OF + off), bb = *(const u32x4*)(OB + off), rr = *(const u32x4*)(R + off);
        float o[8] = {bflo(f.x) + bflo(bb.x), bfhi(f.x) + bfhi(bb.x), bflo(f.y) + bflo(bb.y), bfhi(f.y) + bfhi(bb.y), bflo(f.z) + bflo(bb.z), bfhi(f.z) + bfhi(bb.z), bflo(f.w) + bflo(bb.w), bfhi(f.w) + bfhi(bb.w)};
        float s = 0.f;
#pragma unroll
        for (int e = 0; e < 8; ++e) s += o[e] * o[e];
        const float rstd = rsqrtf(wave_sum(s) * (1.0f / 512.0f) + EPSN);
        u32x4 w; w.x = pk2(o[0] * rstd * g0.x * bflo(rr.x), o[1] * rstd * g0.y * bfhi(rr.x)); w.y = pk2(o[2] * rstd * g0.z * bflo(rr.y), o[3] * rstd * g0.w * bfhi(rr.y));
        w.z = pk2(o[4] * rstd * g1.x * bflo(rr.z), o[5] * rstd * g1.y * bfhi(rr.z)); w.w = pk2(o[6] * rstd * g1.z * bflo(rr.w), o[7] * rstd * g1.w * bfhi(rr.w));
        *(u32x4*)(OG + off) = w;
    }
}

struct EpiBr1 {
    static constexpr bool PERM = true, AFTER_DRAIN = false; const bf16_t* SA; bf16_t* Y1;
    __device__ __forceinline__ void operator()(const f32x4 (&acc)[2][2][4][2], const pg8::Unit& u, int wr, int wc, int fr, int fq) const {
#pragma unroll
        for (int ai = 0; ai < 2; ++ai)
#pragma unroll
            for (int m = 0; m < 4; ++m)
#pragma unroll
                for (int bj = 0; bj < 2; ++bj) { const size_t off = (size_t)(u.pm * 256 + ai * 128 + wr * 64 + m * 16 + fr) * 2048 + u.pn * 256 + bj * 128 + wc * 32 + 8 * fq;
                    const u32x4 g = *(const u32x4*)(SA + off); const f32x4 v0 = acc[ai][bj][m][0], v1 = acc[ai][bj][m][1];
                    u32x4 o; o.x = pk2(v0.x * bflo(g.x), v0.y * bfhi(g.x)); o.y = pk2(v0.z * bflo(g.y), v0.w * bfhi(g.y)); o.z = pk2(v1.x * bflo(g.z), v1.y * bfhi(g.z)); o.w = pk2(v1.z * bflo(g.w), v1.w * bfhi(g.w));
                    *(u32x4*)(Y1 + off) = o; }
    }
};
struct EpiBr2 {
    static constexpr bool PERM = true, AFTER_DRAIN = false; const bf16_t* SB; const bf16_t* Y1; bf16_t* Y;
    __device__ __forceinline__ void operator()(const f32x4 (&acc)[2][2][4][2], const pg8::Unit& u, int wr, int wc, int fr, int fq) const {
#pragma unroll
        for (int ai = 0; ai < 2; ++ai)
#pragma unroll
            for (int m = 0; m < 4; ++m)
#pragma unroll
                for (int bj = 0; bj < 2; ++bj) { const size_t off = (size_t)(u.pm * 256 + ai * 128 + wr * 64 + m * 16 + fr) * 2048 + u.pn * 256 + bj * 128 + wc * 32 + 8 * fq;
                    const u32x4 g = *(const u32x4*)(SB + off), y = *(const u32x4*)(Y1 + off); const f32x4 v0 = acc[ai][bj][m][0], v1 = acc[ai][bj][m][1];
                    u32x4 o; o.x = pk2(bflo(y.x) + v0.x * bflo(g.x), bfhi(y.x) + v0.y * bfhi(g.x)); o.y = pk2(bflo(y.y) + v0.z * bflo(g.y), bfhi(y.y) + v0.w * bfhi(g.y));
                    o.z = pk2(bflo(y.z) + v1.x * bflo(g.z), bfhi(y.z) + v1.y * bfhi(g.z)); o.w = pk2(bflo(y.w) + v1.z * bflo(g.w), bfhi(y.w) + v1.w * bfhi(g.w));
                    *(u32x4*)(Y + off) = o; }
    }
};
struct EpiOut {
    static constexpr bool PERM = false, AFTER_DRAIN = false; const float* x; float* hs1; bf16_t* H1; float* ssq;
    __device__ __forceinline__ void operator()(const f32x4 (&acc)[2][2][4][2], const pg8::Unit& u, int wr, int wc, int fr, int fq) const {
#pragma unroll
        for (int ai = 0; ai < 2; ++ai)
#pragma unroll
            for (int m = 0; m < 4; ++m) { const int r = u.pm * 256 + ai * 128 + wr * 64 + m * 16 + fr; float s = 0.f;
#pragma unroll
                for (int bj = 0; bj < 2; ++bj)
#pragma unroll
                    for (int n = 0; n < 2; ++n) { const size_t off = (size_t)r * 2048 + u.pn * 256 + bj * 128 + wc * 32 + 16 * n + 4 * fq;
                        const f32x4 v = *(const f32x4*)(x + off) + acc[ai][bj][m][n]; st4bf(H1 + off, v); s += (v.x * v.x + v.y * v.y) + (v.z * v.z + v.w * v.w); }
                s += __shfl_xor(s, 16); s += __shfl_xor(s, 32);
                if (fq == 0) atomicAdd(ssq + r, s); }
    }
};
struct EpiQ {
    static constexpr bool PERM = true, AFTER_DRAIN = false; const float* ssq; bf16_t* Qp;
    __device__ __forceinline__ void operator()(const f32x4 (&acc)[2][2][4][2], const pg8::Unit& u, int wr, int wc, int fr, int fq) const {
#pragma unroll
        for (int ai = 0; ai < 2; ++ai)
#pragma unroll
            for (int m = 0; m < 4; ++m) { const int r = u.pm * 256 + ai * 128 + wr * 64 + m * 16 + fr; const float rstd = rsqrtf(ssq[r] * (1.0f / 2048.0f) + EPSN);
#pragma unroll
                for (int bj = 0; bj < 2; ++bj) { const size_t off = (size_t)r * 2048 + u.pn * 256 + bj * 128 + wc * 32 + 8 * fq; const f32x4 v0 = acc[ai][bj][m][0] * rstd, v1 = acc[ai][bj][m][1] * rstd;
                    u32x4 o; o.x = pk2(v0.x, v0.y); o.y = pk2(v0.z, v0.w); o.z = pk2(v1.x, v1.y); o.w = pk2(v1.z, v1.w); *(u32x4*)(Qp + off) = o; } }
    }
};

constexpr int TK_SV = 0, TK_SI = 8192, TK_V2 = 16384, TK_C2 = 20480, TK_TAB = 24576, TK_KEY = 32768;
DI unsigned sortable(float x) { const unsigned u = __float_as_uint(x); return u ^ ((unsigned)((int)u >> 31) | 0x80000000u); }
DI float unsortable(unsigned k) { return __uint_as_float((k & 0x80000000u) ? (k ^ 0x80000000u) : ~k); }
template <int PART> DI void peer_topk(LAS unsigned char* lds, int vcu, int G, int tid, int lane, int wave, int fpm = -1, int fpn = 0) {
    unsigned char* ws = WSB();
    if (PART & 1) { const float* U = INP(20); const float* V = INP(21); const float* gf = INP(17); unsigned* Ub = (unsigned*)(ws + WS_U); unsigned* Vb = (unsigned*)(ws + WS_V);
      for (int ci = vcu * 8 + wave; ci < 32768; ci += G * 8) { f32x4 uu[4], vv[4];
#pragma unroll
          for (int q = 0; q < 4; ++q) { uu[q] = ((const f32x4*)U)[(size_t)ci * 256 + q * 64 + lane]; vv[q] = ((const f32x4*)V)[(size_t)ci * 256 + q * 64 + lane]; }
#pragma unroll
          for (int q = 0; q < 4; ++q) { const f32x4 g = *(const f32x4*)(gf + (ci & 1) * 1024 + q * 256 + lane * 4) * 1024.0f; const f32x4 x = uu[q] * g, y = vv[q] * 64.0f;
              int w = __builtin_amdgcn_cvt_pk_fp8_f32(x.x, x.y, 0, false); w = __builtin_amdgcn_cvt_pk_fp8_f32(x.z, x.w, w, true); Ub[(size_t)ci * 256 + q * 64 + lane] = (unsigned)w;
              int w2 = __builtin_amdgcn_cvt_pk_fp8_f32(y.x, y.y, 0, false); w2 = __builtin_amdgcn_cvt_pk_fp8_f32(y.z, y.w, w2, true); Vb[(size_t)ci * 256 + q * 64 + lane] = (unsigned)w2; } } }
    if (!(PART & 2)) return;
    const bf16_t* Qp = (const bf16_t*)(ws + WS_QP); const bf16_t* KB = (const bf16_t*)(ws + WS_KEYS); int* IDX = (int*)(ws + WS_IDX); float* GATE = (float*)(ws + WS_GATE);
    LAS float* svS = (LAS float*)(lds + TK_SV); LAS int* siS = (LAS int*)(lds + TK_SI); LAS float* v2S = (LAS float*)(lds + TK_V2); LAS int* c2S = (LAS int*)(lds + TK_C2); LAS int* tabS = (LAS int*)(lds + TK_TAB);
    const int fr = lane & 15, g4 = lane >> 4;
    __syncthreads();
    if (tid < 64) { int cnt = 0, code = -1;
        for (int c = 0; c < 256; ++c) { const int i = c >> 4, j = c & 15; if ((i + 1) * (j + 1) <= 16) { if (cnt == tid) code = c; ++cnt; } }
        tabS[tid] = code; }
    const bool fusedq = fpm >= 0; const bool same_h = fusedq || (G % 8) == 0;
    if (same_h) { const int hh = fusedq ? fpn : (vcu & 7);
#pragma unroll
        for (int i = 0; i < 8; ++i) { const int ck = tid + 512 * i, row = ck >> 4, ch = ck & 15;
            *(LAS u32x4*)(lds + TK_KEY + row * 256 + ((ch ^ (row & 15)) * 16)) = *(const u32x4*)(KB + (size_t)(hh * 256 + row) * 128 + ch * 8); } }
    for (int u = fusedq ? 0 : vcu; u < (fusedq ? 4 : 1024); u += (fusedq ? 1 : G)) {
        const int h = fusedq ? fpn : (u & 7), t0 = fusedq ? fpm * 256 + u * 64 : (u >> 3) * 64;
        __syncthreads();
        { const int p = wave >> 2, tb = wave & 3; bf16x8 qf[4];
#pragma unroll
          for (int ks = 0; ks < 4; ++ks) qf[ks] = *(const bf16x8*)(Qp + (size_t)(t0 + tb * 16 + fr) * 2048 + h * 256 + p * 128 + ks * 32 + 8 * g4);
          unsigned key[32];
#pragma unroll
          for (int nb = 0; nb < 8; ++nb) { f32x4 acc = {0.f, 0.f, 0.f, 0.f};
#pragma unroll
              for (int ks = 0; ks < 4; ++ks) { const bf16x8 kv = same_h ? *(const LAS bf16x8*)(lds + TK_KEY + (p * 128 + nb * 16 + fr) * 256 + (((4 * ks + g4) ^ fr) * 16))
                                                                           : *(const bf16x8*)(KB + (size_t)((h * 2 + p) * 128 + nb * 16 + fr) * 128 + ks * 32 + 8 * g4); acc = MFMA16(kv, qf[ks], acc); }
#pragma unroll
              for (int rg = 0; rg < 4; ++rg) key[nb * 4 + rg] = (sortable(acc[rg]) & ~127u) | (unsigned)(127 - (nb * 16 + 4 * g4 + rg)); }
          unsigned prev = 0xffffffffu; const int t = tb * 16 + fr;
#pragma unroll 1
          for (int r = 0; r < 16; ++r) { unsigned m = 0u;
#pragma unroll
              for (int i = 0; i < 32; ++i) { const unsigned c = key[i] < prev ? key[i] : 0u; m = c > m ? c : m; }
              unsigned o = (unsigned)__shfl_xor((int)m, 16); m = o > m ? o : m; o = (unsigned)__shfl_xor((int)m, 32); m = o > m ? o : m;
              if (g4 == 0) { svS[(t * 2 + p) * 16 + r] = unsortable(m & ~127u); siS[(t * 2 + p) * 16 + r] = 127 - (int)(m & 127u); }
              prev = m; } }
        __syncthreads();
        if (tid < 256) { const int t = tid >> 2, q = tid & 3; unsigned key[13];
#pragma unroll
            for (int s = 0; s < 13; ++s) { const int c = q * 13 + s; const int code = tabS[c];
                const float x = svS[(t * 2) * 16 + ((code >> 4) & 15)] + svS[(t * 2 + 1) * 16 + (code & 15)];
                key[s] = code >= 0 ? ((sortable(x) & ~63u) | (unsigned)(63 - c)) : 0u; }
            unsigned prev = 0xffffffffu;
#pragma unroll 1
            for (int r = 0; r < 16; ++r) { unsigned m = 0u;
#pragma unroll
                for (int i = 0; i < 13; ++i) { const unsigned c = key[i] < prev ? key[i] : 0u; m = c > m ? c : m; }
                unsigned o = (unsigned)__shfl_xor((int)m, 1); m = o > m ? o : m; o = (unsigned)__shfl_xor((int)m, 2); m = o > m ? o : m;
                if (q == 0) { v2S[t * 16 + r] = unsortable(m & ~63u); c2S[t * 16 + r] = 63 - (int)(m & 63u); }
                prev = m; } }
        __syncthreads();
#pragma unroll
        for (int it = 0; it < 2; ++it) { const int t = (tid >> 4) + 32 * it, r = tid & 15;
            const float e = __expf(v2S[t * 16 + r] - v2S[t * 16]); float den = e;
            den += __shfl_xor(den, 1); den += __shfl_xor(den, 2); den += __shfl_xor(den, 4); den += __shfl_xor(den, 8);
            const int code = tabS[c2S[t * 16 + r]]; const size_t ob = ((size_t)(t0 + t) * 8 + h) * 16 + r;
            IDX[ob] = siS[(t * 2) * 16 + ((code >> 4) & 15)] * 128 + siS[(t * 2 + 1) * 16 + (code & 15)]; GATE[ob] = e / den; }
    }
}

DI void dec16(const u32x4 q, float* f) {
#pragma unroll
    for (int w = 0; w < 4; ++w) { const f32x2_t lo = __builtin_amdgcn_cvt_pk_f32_fp8((int)q[w], false), hi = __builtin_amdgcn_cvt_pk_f32_fp8((int)q[w], true); f[4 * w] = lo.x; f[4 * w + 1] = lo.y; f[4 * w + 2] = hi.x; f[4 * w + 3] = hi.y; }
}
DI void pick_apply(const u32x4 (&ur)[2], const u32x4 (&vr)[2], const float (&xv)[32], float (&acc)[32], float rstd, float gate) {
    float d = 0.f;
#pragma unroll
    for (int j = 0; j < 2; ++j) { float f[16]; dec16(ur[j], f);
#pragma unroll
        for (int q = 0; q < 16; ++q) d += f[q] * xv[j * 16 + q]; }
    d = wave_sum(d);
    const float w = gate * gelu_f(d * rstd) * (1.0f / 64.0f);
    __builtin_amdgcn_sched_barrier(0);
#pragma unroll
    for (int j = 0; j < 2; ++j) { float f[16]; dec16(vr[j], f);
#pragma unroll
        for (int q = 0; q < 16; ++q) acc[j * 16 + q] += w * f[q]; }
}
DI void peer_gather(LAS unsigned char* lds, int vcu, int G, int tid, int lane, int wave) {
    unsigned char* ws = WSB(); const unsigned char* U8 = ws + WS_U; const unsigned char* V8 = ws + WS_V; const int* IDX = (const int*)(ws + WS_IDX); const float* GATE = (const float*)(ws + WS_GATE);
    const float* ssq = (const float*)(ws + WS_SSQ); float* out = OUTP(); const float* gfin = INP(22); const bf16_t* H1 = (const bf16_t*)(ws + WS_H1);
    LAS unsigned* cnt = (LAS unsigned*)(lds + wave * 2048); LAS unsigned* srt = cnt + 256;
    const bool lockstep = (TR % (G * 8)) == 0;
    for (int t0 = vcu * 8 + wave; t0 < TR; t0 += G * 8) {
        int ln = lane; asm volatile("" : "+v"(ln));
        unsigned pay[2], pos[2];
#pragma unroll
        for (int q = 0; q < 2; ++q) { const int pi = ln + 64 * q; pay[q] = (unsigned)IDX[(size_t)t0 * 128 + pi] | ((unsigned)pi << 14); }
#pragma unroll
        for (int q = 0; q < 4; ++q) cnt[ln + 64 * q] = 0u;
        LDS_WAIT();
#pragma unroll
        for (int q = 0; q < 2; ++q) pos[q] = __hip_atomic_fetch_add(&cnt[(pay[q] & 16383u) >> 6], 1u, __ATOMIC_RELAXED, __HIP_MEMORY_SCOPE_WORKGROUP);
        LDS_WAIT();
        { const unsigned c0 = cnt[4 * ln], c1 = cnt[4 * ln + 1], c2 = cnt[4 * ln + 2], c3 = cnt[4 * ln + 3]; const unsigned tot = c0 + c1 + c2 + c3; unsigned inc = tot;
#pragma unroll
          for (int o = 1; o < 64; o <<= 1) { const unsigned v = (unsigned)__shfl_up((int)inc, o); if (ln >= o) inc += v; }
          const unsigned ex = inc - tot; LDS_WAIT();
          cnt[4 * ln] = ex; cnt[4 * ln + 1] = ex + c0; cnt[4 * ln + 2] = ex + c0 + c1; cnt[4 * ln + 3] = ex + c0 + c1 + c2; }
        LDS_WAIT();
#pragma unroll
        for (int q = 0; q < 2; ++q) srt[cnt[(pay[q] & 16383u) >> 6] + pos[q]] = pay[q];
        LDS_WAIT();
        float xv[32];
#pragma unroll
        for (int j = 0; j < 2; ++j)
#pragma unroll
            for (int q = 0; q < 2; ++q) { const u32x4 a = *(const u32x4*)(H1 + (size_t)t0 * 2048 + j * 1024 + ln * 16 + 8 * q); const int c = j * 16 + 8 * q;
                xv[c] = bflo(a.x); xv[c + 1] = bfhi(a.x); xv[c + 2] = bflo(a.y); xv[c + 3] = bfhi(a.y); xv[c + 4] = bflo(a.z); xv[c + 5] = bfhi(a.z); xv[c + 6] = bflo(a.w); xv[c + 7] = bfhi(a.w); }
        const float rstd = rsqrtf(ssq[t0] * (1.0f / 2048.0f) + EPSN) * (1.0f / 1024.0f);
        float acc[32];
#pragma unroll
        for (int i = 0; i < 32; ++i) acc[i] = 0.f;
        u32x4 ua[2], va[2], ub[2], vb[2], uc[2], vc[2], ud[2], vd[2]; float ga, gb, gc, gd;
#define PG_LOAD(UR, VR, GT, idx) do { if ((idx) < 128) { const unsigned pz = (unsigned)__builtin_amdgcn_readfirstlane((int)srt[(idx)]); const unsigned e = pz & 16383u; \
            _Pragma("unroll") for (int j = 0; j < 2; ++j) { UR[j] = *(const u32x4*)(U8 + (size_t)e * 2048 + j * 1024 + ln * 16); VR[j] = *(const u32x4*)(V8 + (size_t)e * 2048 + j * 1024 + ln * 16); } \
            GT = GATE[(size_t)t0 * 128 + (pz >> 14)]; } } while (0)
        PG_LOAD(ua, va, ga, 0); PG_LOAD(ub, vb, gb, 1); PG_LOAD(uc, vc, gc, 2);
#pragma unroll 1
        for (int i = 0; i < 128; i += 4) {
            if (lockstep && (i & 15) == 0) __builtin_amdgcn_s_barrier();
            PG_LOAD(ud, vd, gd, i + 3); __builtin_amdgcn_sched_barrier(0);
            pick_apply(ua, va, xv, acc, rstd, ga); __builtin_amdgcn_sched_barrier(0);
            PG_LOAD(ua, va, ga, i + 4); __builtin_amdgcn_sched_barrier(0);
            pick_apply(ub, vb, xv, acc, rstd, gb); __builtin_amdgcn_sched_barrier(0);
            PG_LOAD(ub, vb, gb, i + 5); __builtin_amdgcn_sched_barrier(0);
            pick_apply(uc, vc, xv, acc, rstd, gc); __builtin_amdgcn_sched_barrier(0);
            PG_LOAD(uc, vc, gc, i + 6); __builtin_amdgcn_sched_barrier(0);
            pick_apply(ud, vd, xv, acc, rstd, gd); __builtin_amdgcn_sched_barrier(0);
        }
#undef PG_LOAD
        { float* orow = out + (size_t)t0 * 2048 + ln * 16; float s = 0.f;
#pragma unroll
          for (int j = 0; j < 2; ++j)
#pragma unroll
              for (int q = 0; q < 16; ++q) acc[j * 16 + q] += xv[j * 16 + q];
#pragma unroll
          for (int i = 0; i < 32; ++i) s += acc[i] * acc[i];
          const float rs2 = rsqrtf(wave_sum(s) * (1.0f / 2048.0f) + EPSN); const float* gl = gfin + ln * 16;
#pragma unroll
          for (int j = 0; j < 2; ++j)
#pragma unroll
              for (int q = 0; q < 4; ++q) { const f32x4 g = *(const f32x4*)(gl + j * 1024 + 4 * q);
                  *(f32x4*)(orow + j * 1024 + 4 * q) = (f32x4){acc[j * 16 + 4 * q] * g.x * rs2, acc[j * 16 + 4 * q + 1] * g.y * rs2, acc[j * 16 + 4 * q + 2] * g.z * rs2, acc[j * 16 + 4 * q + 3] * g.w * rs2}; } }
    }
}

__global__ void __launch_bounds__(512, 2) mk_fwd(Args args) {
    extern __shared__ __attribute__((aligned(16))) unsigned char lds_raw[];
    LAS unsigned char* lds = (LAS unsigned char*)lds_raw;
    const int tid = threadIdx.x, lane = tid & 63, wave = __builtin_amdgcn_readfirstlane(tid >> 6);
    const int G = gridDim.x, bx = blockIdx.x;
    const int vcu = (G % 8 == 0) ? (bx % 8) * (G / 8) + bx / 8 : bx;
    cg::grid_group grid = cg::this_grid();
    unsigned char* ws = WSB();
    volatile LAS unsigned* xst = (volatile LAS unsigned*)(lds + (LDS_BYTES - 64));
    if (tid < 2) xst[tid] = 0u;
    __syncthreads();
    XcdBarrier xbar; xbar.bar = (unsigned*)(ws + WS_BAR); xbar.x = 0; xbar.st = xst;
    if (args.coop) xbar = xcd_barrier_post((unsigned*)(ws + WS_BAR), xst);
#ifndef PHMASK
#define PHMASK 0x3ff
#endif
#ifndef REP_PH
#define REP_PH -1
#endif
#define PH(k) (((PHMASK >> (k)) & 1) && args.ph_lo <= (k) && (k) < args.ph_hi)
#define SEAM(k) do { if (args.coop && PH(k) && PH((k) + 1)) { if (args.coop == 2) grid.sync(); else xcd_barrier(xbar); } } while (0)
    if (PH(0)) { { p0_prologue(lds, vcu, G, tid, lane, wave); }
#if REP_PH == 0
        grid.sync(); { p0_prologue(lds, vcu, G, tid, lane, wave); }
#endif
    } SEAM(0);
    if (PH(1)) { {
        pg8::Gemm g{(const bf16_t*)(ws + WS_A), (const bf16_t*)(ws + WS_WTIN), TR, 16384, 2048}; pg8::StaticOrder S; S.init(TR, 16384, G, bx);
        EpiIn E{(bf16_t*)(ws + WS_QG), (bf16_t*)(ws + WS_KG), (bf16_t*)(ws + WS_VG), (bf16_t*)(ws + WS_R), (bf16_t*)(ws + WS_QD), (bf16_t*)(ws + WS_KD), (bf16_t*)(ws + WS_VDT), (bf16_t*)(ws + WS_SA), (bf16_t*)(ws + WS_SB),
                (const float*)(ws + WS_ROPE)};
        pg8::gemm_phase<EpiIn, pg8::StaticOrder, true, true>(lds, g, S, E);
        side_gemm(ws, vcu, G, lane, wave);
    }
#if REP_PH == 1
        grid.sync(); {
        pg8::Gemm g{(const bf16_t*)(ws + WS_A), (const bf16_t*)(ws + WS_WTIN), TR, 16384, 2048}; pg8::StaticOrder S; S.init(TR, 16384, G, bx);
        EpiIn E{(bf16_t*)(ws + WS_QG), (bf16_t*)(ws + WS_KG), (bf16_t*)(ws + WS_VG), (bf16_t*)(ws + WS_R), (bf16_t*)(ws + WS_QD), (bf16_t*)(ws + WS_KD), (bf16_t*)(ws + WS_VDT), (bf16_t*)(ws + WS_SA), (bf16_t*)(ws + WS_SB),
                (const float*)(ws + WS_ROPE)};
        pg8::gemm_phase<EpiIn, pg8::StaticOrder, true, true>(lds, g, S, E);
        side_gemm(ws, vcu, G, lane, wave);
    }
#endif
    } SEAM(1);
    if (PH(2)) { { gla_prep(lds, vcu, G, tid, lane, wave); }
#if REP_PH == 2
        grid.sync(); { gla_prep(lds, vcu, G, tid, lane, wave); }
#endif
    } SEAM(2);
    if (PH(3)) { { gla_scan(lds, vcu, G, tid, lane, wave); attn_phase(lds, vcu, G, tid, lane, wave); }
#if REP_PH == 3
        grid.sync(); { gla_scan(lds, vcu, G, tid, lane, wave); attn_phase(lds, vcu, G, tid, lane, wave); }
#endif
#if REP_PH == 30
        grid.sync(); { gla_scan(lds, vcu, G, tid, lane, wave); }
#endif
#if REP_PH == 31
        grid.sync(); { attn_phase(lds, vcu, G, tid, lane, wave); }
#endif
    } SEAM(3);
    if (PH(4)) { { gla_post(vcu, G, lane, wave); }
#if REP_PH == 4
        grid.sync(); { gla_post(vcu, G, lane, wave); }
#endif
    } SEAM(4);
    if (PH(5)) { {
        { pg8::Gemm g{(const bf16_t*)(ws + WS_OG), (const bf16_t*)(ws + WS_WTA), TR, 2048, 2048}; pg8::StaticOrder S; S.init(TR, 2048, G, bx); EpiBr1 E{(const bf16_t*)(ws + WS_SA), (bf16_t*)(ws + WS_Y1)};
          pg8::gemm_phase<EpiBr1, pg8::StaticOrder, true, true>(lds, g, S, E); }
        __syncthreads();
        { pg8::Gemm g{(const bf16_t*)(ws + WS_OD), (const bf16_t*)(ws + WS_WTB), TR, 2048, 2048}; pg8::StaticOrder S; S.init(TR, 2048, G, bx); EpiBr2 E{(const bf16_t*)(ws + WS_SB), (const bf16_t*)(ws + WS_Y1), (bf16_t*)(ws + WS_Y)};
          pg8::gemm_phase<EpiBr2, pg8::StaticOrder, true, true>(lds, g, S, E); }
    }
#if REP_PH == 5
        grid.sync(); {
        { pg8::Gemm g{(const bf16_t*)(ws + WS_OG), (const bf16_t*)(ws + WS_WTA), TR, 2048, 2048}; pg8::StaticOrder S; S.init(TR, 2048, G, bx); EpiBr1 E{(const bf16_t*)(ws + WS_SA), (bf16_t*)(ws + WS_Y1)};
          pg8::gemm_phase<EpiBr1, pg8::StaticOrder, true, true>(lds, g, S, E); }
        __syncthreads();
        { pg8::Gemm g{(const bf16_t*)(ws + WS_OD), (const bf16_t*)(ws + WS_WTB), TR, 2048, 2048}; pg8::StaticOrder S; S.init(TR, 2048, G, bx); EpiBr2 E{(const bf16_t*)(ws + WS_SB), (const bf16_t*)(ws + WS_Y1), (bf16_t*)(ws + WS_Y)};
          pg8::gemm_phase<EpiBr2, pg8::StaticOrder, true, true>(lds, g, S, E); }
    }
#endif
    } SEAM(5);
    if (PH(6)) { { pg8::Gemm g{(const bf16_t*)(ws + WS_Y), (const bf16_t*)(ws + WS_WTO), TR, 2048, 2048}; pg8::StaticOrder S; S.init(TR, 2048, G, bx); EpiOut E{INP(0), OUTP(), (bf16_t*)(ws + WS_H1), (float*)(ws + WS_SSQ)};
        pg8::gemm_phase<EpiOut, pg8::StaticOrder, true, true>(lds, g, S, E); }
#if REP_PH == 6
        grid.sync(); { pg8::Gemm g{(const bf16_t*)(ws + WS_Y), (const bf16_t*)(ws + WS_WTO), TR, 2048, 2048}; pg8::StaticOrder S; S.init(TR, 2048, G, bx); EpiOut E{INP(0), OUTP(), (bf16_t*)(ws + WS_H1), (float*)(ws + WS_SSQ)};
        pg8::gemm_phase<EpiOut, pg8::StaticOrder, true, true>(lds, g, S, E); }
#endif
    } SEAM(6);
    if (PH(7)) { { pg8::Gemm g{(const bf16_t*)(ws + WS_H1), (const bf16_t*)(ws + WS_WTQ), TR, 2048, 2048}; pg8::StaticOrder S; S.init(TR, 2048, G, bx); EpiQ E{(const float*)(ws + WS_SSQ), (bf16_t*)(ws + WS_QP)};
        pg8::gemm_phase<EpiQ, pg8::StaticOrder, true, true>(lds, g, S, E);
        if (G == 256) { pg8::Unit u0; if (S.next(0, u0)) { asm volatile("s_waitcnt vmcnt(0)" ::: "memory"); __syncthreads(); peer_topk<2>(lds, vcu, G, tid, lane, wave, u0.pm, u0.pn); } } }
#if REP_PH == 7
        grid.sync(); { pg8::Gemm g{(const bf16_t*)(ws + WS_H1), (const bf16_t*)(ws + WS_WTQ), TR, 2048, 2048}; pg8::StaticOrder S; S.init(TR, 2048, G, bx); EpiQ E{(const float*)(ws + WS_SSQ), (bf16_t*)(ws + WS_QP)};
        pg8::gemm_phase<EpiQ, pg8::StaticOrder, true, true>(lds, g, S, E);
        if (G == 256) { pg8::Unit u0; if (S.next(0, u0)) { asm volatile("s_waitcnt vmcnt(0)" ::: "memory"); __syncthreads(); peer_topk<2>(lds, vcu, G, tid, lane, wave, u0.pm, u0.pn); } } }
#endif
    } SEAM(7);
    if (PH(8)) { { if (G != 256) peer_topk<3>(lds, vcu, G, tid, lane, wave); }
#if REP_PH == 8
        grid.sync(); { peer_topk<2>(lds, vcu, G, tid, lane, wave); }
#endif
#if REP_PH == 80
        grid.sync(); { peer_topk<1>(lds, vcu, G, tid, lane, wave); }
#endif
#if REP_PH == 81
        grid.sync(); { peer_topk<2>(lds, vcu, G, tid, lane, wave); }
#endif
    } if (G != 256) SEAM(8);
    if (PH(9)) { peer_gather(lds, vcu, G, tid, lane, wave); }
#undef PH
#undef SEAM
}

#ifndef MK_COOP
#define MK_COOP 1
#endif
extern "C" void kernel_launch(void* const* d_in, const int* in_sizes, int n_in, void* d_out, int out_size, void* d_ws, size_t ws_size, hipStream_t stream) {
    static int grid = 0;
    if (grid == 0) {
        if (n_in != 23 || out_size != TR * DM || ws_size < WS_END) { fprintf(stderr, "kernel_launch: unexpected problem (n_in %d, out %d, ws %zu)\n", n_in, out_size, ws_size); grid = -1; return; }
        int dev = 0, cus = 0, per_cu = 0;
        if (hipGetDevice(&dev) != hipSuccess || hipDeviceGetAttribute(&cus, hipDeviceAttributeMultiprocessorCount, dev) != hipSuccess) { grid = -1; return; }
        if (hipFuncSetAttribute((const void*)mk_fwd, hipFuncAttributeMaxDynamicSharedMemorySize, LDS_BYTES) != hipSuccess) { fprintf(stderr, "kernel_launch: hipFuncSetAttribute failed\n"); grid = -1; return; }
        if (hipOccupancyMaxActiveBlocksPerMultiprocessor(&per_cu, (const void*)mk_fwd, 512, LDS_BYTES) != hipSuccess || per_cu < 1) { fprintf(stderr, "kernel_launch: occupancy query says %d\n", per_cu); (void)hipGetLastError(); per_cu = 1; }
        grid = cus;
        if (grid % 8) grid -= grid % 8;
    }
    if (grid <= 0) return;
    Args a{};
    for (int i = 0; i < 23; ++i) a.in[i] = (const float*)d_in[i];
    a.out = (float*)d_out; a.ws = (unsigned char*)d_ws;
#if MK_COOP
    if (hipMemsetAsync((unsigned char*)d_ws + WS_BAR, 0, XCD_BAR_WORDS * 4, stream) != hipSuccess) { fprintf(stderr, "kernel_launch: hipMemsetAsync of the barrier words failed\n"); return; }
    a.ph_lo = 0; a.ph_hi = NPH; a.coop = 1;
    void* kargs[] = {&a};
    hipError_t e = hipLaunchCooperativeKernel((const void*)mk_fwd, dim3(grid), dim3(512), kargs, LDS_BYTES, stream);
    if (e != hipSuccess) fprintf(stderr, "cooperative launch failed: %s (grid %d)\n", hipGetErrorString(e), grid);
#else
    for (int p = 0; p < NPH; ++p) { a.ph_lo = p; a.ph_hi = p + 1; a.coop = 0; hipLaunchKernelGGL(mk_fwd, dim3(grid), dim3(512), LDS_BYTES, stream, a); }
#endif
}
```

```cpp
#include <hip/hip_runtime.h>
#include <hip/hip_cooperative_groups.h>
#include <cstdio>
#include <cstdint>
namespace cg = cooperative_groups;
namespace pg8 {
#define PG8_LAS __attribute__((address_space(3)))
typedef unsigned short bf16_t;
typedef short bf16x8 __attribute__((ext_vector_type(8)));
typedef float f32x4 __attribute__((ext_vector_type(4)));
typedef unsigned u32x4 __attribute__((ext_vector_type(4)));
constexpr int BM = 256, BK = 64, HALF = 128, HTB = HALF * BK * 2  , STAGE_BYTES = 8 * HTB, NXCD = 8, WGM = 8;

__host__ __device__ __forceinline__ int lds_byte(int r, int c) { const int st = (r >> 4) * 2 + (c >> 5), rr = r & 15, cc = c & 31, ob = rr * 64 + cc * 2; return st * 1024 + (ob ^ (((ob >> 9) & 1) << 5)); }
__host__ __device__ __forceinline__ void stage_rc(int b, int& R, int& C) { const int st = b / 1024, sb = b % 1024, swz = sb ^ (((sb >> 9) & 1) << 5); R = (st >> 1) * 16 + swz / 64; C = (st & 1) * 32 + (swz % 64) / 2; }
__host__ __device__ __forceinline__ int perm32(int rho) { const int n = rho >> 4, i = rho & 15; return 8 * (i >> 2) + 4 * n + (i & 3); }

struct Unit { int pm, pn; };
struct Gemm { const bf16_t* A; const bf16_t* Bt; int M, N, K; };

struct StaticOrder {
    int nM, nN, nwg, G, c;
    __host__ __device__ void init(int M, int N, int G_, int c_) { nM = M / BM; nN = N / BM; nwg = nM * nN; G = G_; c = c_; }
    __host__ __device__ __forceinline__ bool next(int i, Unit& u) const {
        const long L = (long)i * G + c; if (L >= nwg) return false;
        int wgid = (int)L; { const int q = nwg / NXCD, r = nwg % NXCD, xcd = wgid % NXCD, off = wgid / NXCD; wgid = (xcd < r ? xcd * (q + 1) : r * (q + 1) + (xcd - r) * q) + off; }
        const int nig = WGM * nN, gid = wgid / nig, fm = gid * WGM, gsz = (nM - fm) < WGM ? (nM - fm) : WGM;
        u.pm = fm + ((wgid % nig) % gsz); u.pn = (wgid % nig) / gsz; return true;
    }
    __device__ __forceinline__ void a_ready(const Unit&) const {}
    __device__ __forceinline__ void done(const Unit&) const {}
};

template <class Epi, class Sched, bool ALIGN_EPI = false, bool SP2 = false>
__device__ __forceinline__ void gemm_phase(PG8_LAS unsigned char* lds, const Gemm g, const Sched& S, const Epi& E) {
    const int tid = threadIdx.x, wid = __builtin_amdgcn_readfirstlane(tid >> 6), lane = tid & 63, wr = wid >> 2, wc = wid & 3, fr = lane & 15, fq = lane >> 4;
    const int K = g.K, nt = K / BK;
    unsigned voffA[2], voffB[2];
#pragma unroll
    for (int i = 0; i < 2; ++i) { int R, C; stage_rc(tid * 16 + i * 8192, R, C); const int Rb = Epi::PERM ? ((R & ~31) + perm32(R & 31)) : R;
        voffA[i] = (unsigned)(R * K + C) * 2u; voffB[i] = (unsigned)(Rb * K + C) * 2u; }
    const size_t kstep = (size_t)(BK * 2);
    const size_t hstep = (size_t)HALF * K * 2;
    const size_t tstep = 2 * hstep;
    const unsigned ldsw = (unsigned)wid * 1024u;
    const int aoff = lds_byte(wr * 64 + fr, fq * 8), boff = lds_byte(wc * 32 + fr, fq * 8);
#define PG8_SA(b, h) (((b) * 2 + (h)) * HTB)
#define PG8_SB(b, h) ((4 + (b) * 2 + (h)) * HTB)
#define PG8_STAGE(bufoff, gbase, voff) do { _Pragma("unroll") for (int _i = 0; _i < 2; ++_i) \
        __builtin_amdgcn_global_load_lds((const unsigned*)((const char*)(gbase) + (voff)[_i]), (PG8_LAS unsigned*)(lds + (bufoff) + ldsw + _i * 8192), 16, 0, 0); } while (0)
#define PG8_LDA(dst, b, h) do { _Pragma("unroll") for (int m = 0; m < 4; ++m) _Pragma("unroll") for (int k = 0; k < 2; ++k) dst[m][k] = *(const PG8_LAS bf16x8*)(lds + PG8_SA(b, h) + aoff + m * 2048 + k * 1024); } while (0)
#define PG8_LDB(dst, b, h) do { _Pragma("unroll") for (int n = 0; n < 2; ++n) _Pragma("unroll") for (int k = 0; k < 2; ++k) dst[n][k] = *(const PG8_LAS bf16x8*)(lds + PG8_SB(b, h) + boff + n * 2048 + k * 1024); } while (0)
#define PG8_MMA(ai, bj, At, Bt) do { __builtin_amdgcn_s_setprio(1); _Pragma("unroll") for (int m = 0; m < 4; ++m) _Pragma("unroll") for (int n = 0; n < 2; ++n) _Pragma("unroll") for (int k = 0; k < 2; ++k) \
        acc[ai][bj][m][n] = __builtin_amdgcn_mfma_f32_16x16x32_bf16(Bt[n][k], At[m][k], acc[ai][bj][m][n], 0, 0, 0); __builtin_amdgcn_s_setprio(0); } while (0)
#define PG8_WAIT_V(n) asm volatile("s_waitcnt vmcnt(" #n ")" ::: "memory")
#define PG8_WAIT_L(n) asm volatile("s_waitcnt lgkmcnt(" #n ")" ::: "memory")
#define PG8_BAR __builtin_amdgcn_s_barrier()
#define PG8_SCHED __builtin_amdgcn_sched_barrier(0)
    Unit cur, nxt; int ui = 0;
    if (!S.next(0, cur)) return;
    f32x4 acc[2][2][4][2];
#pragma unroll
    for (int a = 0; a < 2; ++a)
#pragma unroll
        for (int b = 0; b < 2; ++b)
#pragma unroll
            for (int m = 0; m < 4; ++m)
#pragma unroll
                for (int n = 0; n < 2; ++n) acc[a][b][m][n] = (f32x4){0.f, 0.f, 0.f, 0.f};
    bf16x8 At[4][2], B0[2][2], B1[2][2];
    const char* cA = (const char*)g.A + (size_t)cur.pm * tstep; const char* cB = (const char*)g.Bt + (size_t)cur.pn * tstep;
    S.a_ready(cur);
    if constexpr (SP2) {
        PG8_STAGE(PG8_SB(0, 0), cB, voffB); PG8_STAGE(PG8_SB(0, 1), cB + hstep, voffB); PG8_STAGE(PG8_SA(0, 0), cA, voffA); PG8_STAGE(PG8_SA(0, 1), cA + hstep, voffA);
        if (wr == 1) PG8_BAR;
        PG8_WAIT_V(2); PG8_BAR;
        PG8_STAGE(PG8_SB(1, 0), cB + kstep, voffB); PG8_STAGE(PG8_SA(1, 0), cA + kstep, voffA); PG8_STAGE(PG8_SB(1, 1), cB + hstep + kstep, voffB);
        PG8_WAIT_V(6); PG8_BAR;
    } else {
        PG8_STAGE(PG8_SB(0, 0), cB, voffB); PG8_STAGE(PG8_SA(0, 0), cA, voffA); PG8_STAGE(PG8_SB(0, 1), cB + hstep, voffB); PG8_STAGE(PG8_SA(0, 1), cA + hstep, voffA);
        if (wr == 1) PG8_BAR;
        PG8_WAIT_V(4); PG8_BAR;
        PG8_STAGE(PG8_SB(1, 0), cB + kstep, voffB); PG8_STAGE(PG8_SA(1, 0), cA + kstep, voffA); PG8_STAGE(PG8_SB(1, 1), cB + hstep + kstep, voffB);
        PG8_WAIT_V(6); PG8_BAR;
    }
    for (;;) {
        const bool has_next = S.next(ui + 1, nxt);
        const char* nA = has_next ? (const char*)g.A + (size_t)nxt.pm * tstep : cA; const char* nB = has_next ? (const char*)g.Bt + (size_t)nxt.pn * tstep : cB;
        for (int t = 0; t < nt; t += 2) {
            const bool last = (t == nt - 2);
            const char* a1 = cA + (size_t)(t + 1) * kstep;
            const char* a2 = last ? nA : cA + (size_t)(t + 2) * kstep; const char* b2 = last ? nB : cB + (size_t)(t + 2) * kstep;
            const char* a3 = a2 + kstep; const char* b3 = b2 + kstep;
            if (last && has_next) S.a_ready(nxt);
            if constexpr (SP2) {
            PG8_LDB(B0, 0, 0); PG8_LDB(B1, 0, 1); PG8_SCHED; PG8_LDA(At, 0, 0); PG8_STAGE(PG8_SA(1, 1), a1 + hstep, voffA);
            PG8_WAIT_V(8); PG8_WAIT_L(0); PG8_BAR; PG8_MMA(0, 0, At, B0); PG8_MMA(0, 1, At, B1); PG8_BAR; PG8_SCHED;
            PG8_LDA(At, 0, 1); PG8_STAGE(PG8_SB(0, 0), b2, voffB); PG8_STAGE(PG8_SB(0, 1), b2 + hstep, voffB); PG8_STAGE(PG8_SA(0, 0), a2, voffA);
            PG8_WAIT_V(8); PG8_WAIT_L(0); PG8_BAR; PG8_MMA(1, 0, At, B0); PG8_MMA(1, 1, At, B1); PG8_BAR; PG8_SCHED;
            PG8_LDB(B0, 1, 0); PG8_LDB(B1, 1, 1); PG8_SCHED; PG8_LDA(At, 1, 0); PG8_STAGE(PG8_SA(0, 1), a2 + hstep, voffA);
            PG8_WAIT_V(8); PG8_WAIT_L(0); PG8_BAR; PG8_MMA(0, 0, At, B0); PG8_MMA(0, 1, At, B1); PG8_BAR; PG8_SCHED;
            PG8_LDA(At, 1, 1); PG8_STAGE(PG8_SB(1, 0), b3, voffB); PG8_STAGE(PG8_SB(1, 1), b3 + hstep, voffB); PG8_STAGE(PG8_SA(1, 0), a3, voffA);
            PG8_WAIT_V(8); PG8_WAIT_L(0); PG8_BAR; PG8_MMA(1, 0, At, B0); PG8_MMA(1, 1, At, B1); PG8_BAR; PG8_SCHED;
            } else {
            PG8_LDB(B0, 0, 0); PG8_SCHED; PG8_LDA(At, 0, 0); PG8_STAGE(PG8_SA(1, 1), a1 + hstep, voffA);
            PG8_WAIT_L(8); PG8_BAR; PG8_WAIT_L(0); PG8_MMA(0, 0, At, B0); PG8_BAR; PG8_SCHED;
            PG8_LDB(B1, 0, 1); PG8_STAGE(PG8_SB(0, 0), b2, voffB);
            PG8_BAR; PG8_WAIT_L(0); PG8_MMA(0, 1, At, B1); PG8_BAR;
            PG8_LDA(At, 0, 1); PG8_STAGE(PG8_SA(0, 0), a2, voffA);
            PG8_BAR; PG8_WAIT_L(0); PG8_MMA(1, 0, At, B0); PG8_BAR; PG8_SCHED;
            PG8_STAGE(PG8_SB(0, 1), b2 + hstep, voffB);
            PG8_WAIT_V(6); PG8_BAR; PG8_MMA(1, 1, At, B1); PG8_BAR;
            PG8_LDB(B0, 1, 0); PG8_SCHED; PG8_LDA(At, 1, 0); PG8_STAGE(PG8_SA(0, 1), a2 + hstep, voffA);
            PG8_WAIT_L(8); PG8_BAR; PG8_WAIT_L(0); PG8_MMA(0, 0, At, B0); PG8_BAR; PG8_SCHED;
            PG8_LDB(B1, 1, 1); PG8_STAGE(PG8_SB(1, 0), b3, voffB);
            PG8_BAR; PG8_WAIT_L(0); PG8_MMA(0, 1, At, B1); PG8_BAR;
            PG8_LDA(At, 1, 1); PG8_STAGE(PG8_SA(1, 0), a3, voffA);
            PG8_BAR; PG8_WAIT_L(0); PG8_MMA(1, 0, At, B0); PG8_BAR; PG8_SCHED;
            PG8_STAGE(PG8_SB(1, 1), b3 + hstep, voffB);
            PG8_WAIT_V(6); PG8_BAR; PG8_MMA(1, 1, At, B1); PG8_BAR;
            }
        }
        if constexpr (ALIGN_EPI) { if (wr == 0) PG8_BAR; }
        if constexpr (!Epi::AFTER_DRAIN) { E(acc, cur, wr, wc, fr, fq); S.done(cur); }
        if (!has_next) break;
#pragma unroll
        for (int a = 0; a < 2; ++a)
#pragma unroll
            for (int b = 0; b < 2; ++b)
#pragma unroll
                for (int m = 0; m < 4; ++m)
#pragma unroll
                    for (int n = 0; n < 2; ++n) acc[a][b][m][n] = (f32x4){0.f, 0.f, 0.f, 0.f};
        cur = nxt; cA = nA; cB = nB; ++ui;
        if constexpr (ALIGN_EPI) { if (wr == 1) PG8_BAR; }
    }
    PG8_WAIT_V(0);
    if constexpr (!ALIGN_EPI) { if (wr == 0) PG8_BAR; }
    PG8_BAR;
    if constexpr (Epi::AFTER_DRAIN) { E.fused(acc, cur, wr, wc, fr, fq, lds, wid, lane); S.done(cur); }
#undef PG8_SA
#undef PG8_SB
#undef PG8_STAGE
#undef PG8_LDA
#undef PG8_LDB
#undef PG8_MMA
#undef PG8_WAIT_V
#undef PG8_WAIT_L
#undef PG8_BAR
#undef PG8_SCHED
}
}

#define LAS __attribute__((address_space(3)))
typedef unsigned short bf16_t;
typedef short bf16x8 __attribute__((ext_vector_type(8)));
typedef short s16x4 __attribute__((ext_vector_type(4)));
typedef float f32x4 __attribute__((ext_vector_type(4)));
typedef float f32x16 __attribute__((ext_vector_type(16)));
typedef unsigned u32x4 __attribute__((ext_vector_type(4)));
typedef unsigned u32x2 __attribute__((ext_vector_type(2)));
typedef float f32x2_t __attribute__((ext_vector_type(2)));
typedef __bf16 bf16x2_t __attribute__((ext_vector_type(2)));
#define DI __device__ __forceinline__
#define LDS_WAIT() asm volatile("s_waitcnt lgkmcnt(0)" ::: "memory")
#define LDS_BARRIER() do { asm volatile("s_waitcnt lgkmcnt(0)" ::: "memory"); __builtin_amdgcn_s_barrier(); asm volatile("" ::: "memory"); } while (0)
#define MFMA16(a, b, c) __builtin_amdgcn_mfma_f32_16x16x32_bf16((a), (b), (c), 0, 0, 0)
#define MFMA32(a, b, c) __builtin_amdgcn_mfma_f32_32x32x16_bf16((a), (b), (c), 0, 0, 0)

DI unsigned pk2(float lo, float hi) { f32x2_t v = {lo, hi}; bf16x2_t b = __builtin_convertvector(v, bf16x2_t); return __builtin_bit_cast(unsigned, b); }
DI bf16_t f2bf(float x) { return (bf16_t)(pk2(x, 0.f) & 0xffffu); }
DI float bf2f(bf16_t b) { return __uint_as_float(((unsigned)b) << 16); }
DI float bflo(unsigned w) { return __uint_as_float(w << 16); }
DI float bfhi(unsigned w) { return __uint_as_float(w & 0xffff0000u); }
DI float wave_sum(float v) {
#pragma unroll
    for (int o = 1; o < 64; o <<= 1) v += __shfl_xor(v, o);
    return v;
}
DI float sigmoidf_(float x) { return 1.0f / (1.0f + __expf(-x)); }
DI float gelu_f(float v) {
    const float av = fabsf(v), d = av * 0.2316418882f + 1.0f; const float t = __builtin_amdgcn_rcpf(d);
    float q = t * 0.5307027145f + (-0.7265760135f); q = q * t + 0.7107068705f; q = q * t + (-0.142248368f); q = q * t + 0.127414796f; q = q * t;
    const float s = (v * v) * (-0.72134752044f); const float e = __builtin_amdgcn_exp2f(s); const float m = v * (q * e), r = v - m; return v < 0.f ? m : r;
}

constexpr int NB = 4, SEQ = 2048, DM = 2048, TR = NB * SEQ;
constexpr int LKP = 2112, LK = 2064;
constexpr int MROWS = 8448, NIN = 16640;
constexpr float EPSN = 1e-6f;
constexpr float C2Q = 0.12751743082459868f;
constexpr int NPH = 10;
constexpr size_t MiB = 1u << 20;
constexpr size_t WS_SSQ = 0, WS_BAR = 65536;
constexpr size_t WS_WTA = 1 * MiB, WS_WTB = 9 * MiB, WS_WTO = 17 * MiB, WS_WTQ = 25 * MiB, WS_KEYS = 33 * MiB, WS_ROPE = 33 * MiB + 512 * 1024, WS_LR = 34 * MiB;
constexpr size_t WS_SA = 36 * MiB, WS_SB = 68 * MiB, WS_R = 100 * MiB, WS_VG = 132 * MiB, WS_QD = 165 * MiB, WS_KD = 197 * MiB, WS_VDT = 230 * MiB;
constexpr size_t WS_WTIN = 263 * MiB, WS_A = 328 * MiB, WS_QG = 361 * MiB, WS_KG = 361 * MiB + 16 * MiB + 512 * 1024, WS_QIN = 394 * MiB, WS_KST = 427 * MiB, WS_AMAT = 460 * MiB;
constexpr size_t WS_DEC = 468 * MiB + 256 * 1024;
constexpr size_t WS_OF = 263 * MiB, WS_OB = 295 * MiB, WS_OG = 394 * MiB, WS_Y1 = 197 * MiB, WS_Y = 230 * MiB, WS_H1 = 263 * MiB, WS_QP = 295 * MiB;
constexpr size_t WS_OD = 361 * MiB;
constexpr size_t WS_IDX = 132 * MiB, WS_GATE = 136 * MiB, WS_U = 470 * MiB, WS_V = 328 * MiB, WS_END = 502 * MiB;
constexpr int LDS_BYTES = 147456;

struct Args { const float* in[23]; float* out; unsigned char* ws; int ph_lo, ph_hi, coop, pad; };
typedef __attribute__((address_space(4))) const unsigned long long cu64_t;
template <int IDX> DI unsigned long long karg64() { unsigned long long v; cu64_t* kp = (cu64_t*)__builtin_amdgcn_kernarg_segment_ptr();
    asm volatile("s_load_dwordx2 %0, %1, %2\n\ts_waitcnt lgkmcnt(0)" : "=s"(v) : "s"(kp), "n"(IDX * 8) : "memory"); return v; }
template <int IDX> DI unsigned char* kptr() { typedef __attribute__((address_space(1))) unsigned char gu8_t; return (unsigned char*)(gu8_t*)karg64<IDX>(); }
#define INP(k) ((const float*)kptr<(k)>())
#define WSB() (kptr<24>())
#define OUTP() ((float*)kptr<23>())

#define XB_TMO      128
#define XB_XCNT(j)  (256  + 64 * (j))
#define XB_XSUB(j)  (1280 + 64 * (j))
#define XB_XGEN(j)  (2304 + 64 * (j))
#define XB_TOP      3328
#define XB_TOPGEN   3392
#define XCD_BAR_WORDS 3456
#define XB_SPIN_CAP (1u << 18)

__device__ __forceinline__ unsigned xb_ld(unsigned* p)              { return __hip_atomic_load(p, __ATOMIC_RELAXED, __HIP_MEMORY_SCOPE_AGENT); }
__device__ __forceinline__ unsigned xb_add(unsigned* p, unsigned v) { return __hip_atomic_fetch_add(p, v, __ATOMIC_RELAXED, __HIP_MEMORY_SCOPE_AGENT); }
__device__ __forceinline__ unsigned xb_xcc_id() { return (unsigned)__builtin_amdgcn_s_getreg((3 << 11) | 20) & 0xFu; }
#define XB_SPIN(cond, bar) do { unsigned _sp = 0; while (cond) { __builtin_amdgcn_s_sleep(1); \
    if ((++_sp & 255u) == 0u) { if (xb_ld(&(bar)[XB_TMO])) break; if (_sp > XB_SPIN_CAP) { atomicAdd(&(bar)[XB_TMO], 1u); break; } } } } while (0)

struct XcdBarrier {
    unsigned* bar; unsigned x;
    volatile LAS unsigned* st;
};

__device__ __forceinline__ XcdBarrier xcd_barrier_post(unsigned* bar, volatile LAS unsigned* st) {
    XcdBarrier b; b.bar = bar; b.x = xb_xcc_id(); b.st = st;
    if (threadIdx.x == 0) (void)xb_add(&bar[XB_XCNT(b.x)], 1u);
    return b;
}
__device__ __forceinline__ void xcd_barrier_complete(unsigned* bar, unsigned x, unsigned& nloc, unsigned& nx) {
    const unsigned G = gridDim.x * gridDim.y * gridDim.z;
    unsigned sum, cnt, mine, sp = 0u;
    for (;;) {
        sum = 0u; cnt = 0u; mine = 0u;
#pragma unroll
        for (unsigned j = 0; j < 16; ++j) { const unsigned c = xb_ld(&bar[XB_XCNT(j)]); sum += c; cnt += (c > 0u) ? 1u : 0u; mine = (j == x) ? c : mine; }
        if (sum == G) break;
        __builtin_amdgcn_s_sleep(1);
        if ((++sp & 255u) == 0u) { if (xb_ld(&bar[XB_TMO])) break; if (sp > XB_SPIN_CAP) { atomicAdd(&bar[XB_TMO], 1u); break; } }
    }
    nloc = mine > 0u ? mine : 1u; nx = cnt > 0u ? cnt : 1u;
}

__device__ __forceinline__ void xcd_barrier(const XcdBarrier& b) {
    asm volatile("s_waitcnt vmcnt(0)" ::: "memory");
    __syncthreads();
    if (threadIdx.x == 0) {
        unsigned* bar = b.bar;
        __builtin_amdgcn_s_waitcnt(0);
        unsigned nloc = b.st[0], nx = b.st[1];
        if (nloc == 0u) { xcd_barrier_complete(bar, b.x, nloc, nx); b.st[0] = nloc; b.st[1] = nx; }
        const unsigned old = xb_add(&bar[XB_XSUB(b.x)], 1u);
        const unsigned gen = old / nloc;
        if (old + 1u == (gen + 1u) * nloc) {
            __builtin_amdgcn_fence(__ATOMIC_RELEASE, "agent");
            asm volatile("s_waitcnt vmcnt(0)" ::: "memory");
            const unsigned og = xb_add(&bar[XB_TOP], 1u);
            const unsigned tg = og / nx;
            if (og + 1u == (tg + 1u) * nx) xb_add(&bar[XB_TOPGEN], 1u);
            else XB_SPIN(xb_ld(&bar[XB_TOPGEN]) == tg, bar);
            __builtin_amdgcn_fence(__ATOMIC_ACQUIRE, "agent");
            xb_add(&bar[XB_XGEN(b.x)], 1u);
            asm volatile("s_waitcnt vmcnt(0)" ::: "memory");
        } else {
            XB_SPIN(xb_ld(&bar[XB_XGEN(b.x)]) == gen, bar);
            __builtin_amdgcn_fence(__ATOMIC_ACQUIRE, "agent");
            asm volatile("s_waitcnt vmcnt(0)" ::: "memory");
        }
    }
    __syncthreads();
}


template <bool REMAP> DI void transpose_tile(const float* __restrict__ W, int N, bf16_t* __restrict__ WT, const float* __restrict__ g, LAS unsigned char* lds, int k0, int n0, int tid, int lane, int wave) {
    f32x4 v[16];
    const bool inr = (n0 + lane * 4) < N;
#pragma unroll
    for (int i = 0; i < 16; ++i) { const int k = k0 + wave * 16 + i; v[i] = inr ? *(const f32x4*)(W + (size_t)k * N + n0 + lane * 4) : (f32x4){0.f, 0.f, 0.f, 0.f}; if (g) v[i] = v[i] * g[k]; }
#pragma unroll
    for (int e = 0; e < 4; ++e) { u32x4 lo, hi;
        lo.x = pk2(v[0][e], v[1][e]); lo.y = pk2(v[2][e], v[3][e]); lo.z = pk2(v[4][e], v[5][e]); lo.w = pk2(v[6][e], v[7][e]);
        hi.x = pk2(v[8][e], v[9][e]); hi.y = pk2(v[10][e], v[11][e]); hi.z = pk2(v[12][e], v[13][e]); hi.w = pk2(v[14][e], v[15][e]);
        LAS unsigned char* p = lds + (lane * 4 + e) * 272 + wave * 32; *(LAS u32x4*)p = lo; *(LAS u32x4*)(p + 16) = hi; }
    __syncthreads();
#pragma unroll
    for (int j = 0; j < 8; ++j) { const int c = tid + 512 * j, n = c >> 4, ch = c & 15; const int ns = n0 + n; if (ns >= N) continue;
        const int dr = REMAP ? (ns < 6144 ? ns : (ns < 6176 ? 16384 + (ns - 6144) : ns - 32)) : ns;
        *(u32x4*)(WT + (size_t)dr * 2048 + k0 + ch * 8) = *(const LAS u32x4*)(lds + n * 272 + ch * 16); }
    __syncthreads();
}
DI void zero_chunks(unsigned char* base, int nchunks, int gt, int NT) { const u32x4 z = {0u, 0u, 0u, 0u}; for (int i = gt; i < nchunks; i += NT) *(u32x4*)(base + (size_t)i * 16) = z; }

DI void p0_prologue(LAS unsigned char* lds, int vcu, int G, int tid, int lane, int wave) {
    unsigned char* ws = WSB();
    const int gw = vcu * 8 + wave, NGW = G * 8, gt = vcu * 512 + tid, NT = G * 512;
    const float* w_in = INP(3); const float* g_mix = INP(2);
    { constexpr int T_IN = 16 * 65, T_SQ = 16 * 8, NT_ALL = T_IN + 4 * T_SQ;
      for (int it = vcu; it < NT_ALL; it += G) {
          if (it < T_IN) { transpose_tile<true>(w_in, 16416, (bf16_t*)(ws + WS_WTIN), g_mix, lds, (it / 65) * 128, (it % 65) * 256, tid, lane, wave); continue; }
          int r = it - T_IN; const int which = r / T_SQ; r -= which * T_SQ;
          const float* W = which == 0 ? INP(14) : which == 1 ? INP(15) : which == 2 ? INP(16) : INP(18);
          bf16_t* WT = (bf16_t*)(ws + (which == 0 ? WS_WTA : which == 1 ? WS_WTB : which == 2 ? WS_WTO : WS_WTQ));
          transpose_tile<false>(W, 2048, WT, which == 3 ? INP(17) : nullptr, lds, (r / 8) * 128, (r % 8) * 256, tid, lane, wave); } }
    for (int m = gw; m < MROWS; m += NGW) {
        bf16_t* orow = (bf16_t*)(ws + WS_A) + (size_t)m * 2048;
        if (m >= TR + 16) { const u32x4 z = {0u, 0u, 0u, 0u};
#pragma unroll
            for (int j = 0; j < 4; ++j) ((u32x4*)orow)[lane + 64 * j] = z; continue; }
        const float* xr = m < TR ? INP(0) + (size_t)m * 2048 : INP(1) + (size_t)(m - TR) * 2048;
        f32x4 v[8]; float s = 0.f;
#pragma unroll
        for (int j = 0; j < 8; ++j) { v[j] = ((const f32x4*)xr)[lane + 64 * j]; s += (v[j].x * v[j].x + v[j].y * v[j].y) + (v[j].z * v[j].z + v[j].w * v[j].w); }
        const float rstd = rsqrtf(wave_sum(s) * (1.0f / 2048.0f) + EPSN);
#pragma unroll
        for (int j = 0; j < 8; ++j) { u32x2 o; o.x = pk2(v[j].x * rstd, v[j].y * rstd); o.y = pk2(v[j].z * rstd, v[j].w * rstd); ((u32x2*)orow)[lane + 64 * j] = o; }
    }
    { const float* keys = INP(19); bf16_t* kb = (bf16_t*)(ws + WS_KEYS);
      for (int i = gt; i < 32768; i += NT) { const f32x4 x0 = ((const f32x4*)keys)[2 * i], x1 = ((const f32x4*)keys)[2 * i + 1];
          u32x4 o; o.x = pk2(x0.x, x0.y); o.y = pk2(x0.z, x0.w); o.z = pk2(x1.x, x1.y); o.w = pk2(x1.z, x1.w); ((u32x4*)kb)[i] = o; } }
    { float* rope = (float*)(ws + WS_ROPE);
      for (int i = gt; i < LK * 16; i += NT) { const int pos = i >> 4, fi = i & 15;
          const double cs[16] = {0.15915494309189535, 0.0700865215877985, 0.03086376340470123, 0.013591370636193905, 0.005985185712713705, 0.002635675898667414, 0.001160663641240061, 0.0005111175045375439,
                                 0.00022507907903927653, 9.911730936901935e-05, 4.364795279280289e-05, 1.9221100684944863e-05, 8.464330808241401e-06, 3.727408601915352e-06, 1.6414262627950345e-06, 7.228293068832865e-07};
          double c = cs[0];
#pragma unroll
          for (int q = 1; q < 16; ++q) c = (fi == q) ? cs[q] : c;
          const double rev = (double)pos * c; const float fr = (float)(rev - __builtin_floor(rev));
          rope[2 * i] = __builtin_amdgcn_cosf(fr); rope[2 * i + 1] = __builtin_amdgcn_sinf(fr); } }
    for (int i = gt; i < TR; i += NT) ((float*)(ws + WS_SSQ))[i] = 0.f;
    for (int b = 0; b < NB; ++b) {
        zero_chunks(ws + WS_QG + (size_t)b * LKP * 1024 * 2, 64 * 1024 * 2 / 16, gt, NT);
        zero_chunks(ws + WS_KG + (size_t)b * LKP * 1024 * 2, 48 * 1024 * 2 / 16, gt, NT);
        { const u32x4 z = {0u, 0u, 0u, 0u}; for (int i = gt; i < 2048 * 8; i += NT) *(u32x4*)(ws + WS_VG + ((size_t)(b * 2048 + i / 8) * LKP) * 2 + (i % 8) * 16) = z; }
        zero_chunks(ws + WS_KD + ((size_t)b * LKP + LK) * 2048 * 2, 48 * 2048 * 2 / 16, gt, NT);
    }
    { const u32x4 z = {0u, 0u, 0u, 0u}; for (int i = gt; i < 8192 * 6; i += NT) { const int row = i / 6, c = i % 6; *(u32x4*)(ws + WS_VDT + (size_t)row * (LKP * 2) + LK * 2 + c * 16) = z; } }
}

DI int permpos(int pos) { return (pos & ~31) | ((pos & 12) << 1) | ((pos & 16) >> 2) | (pos & 3); }
DI void st4bf(bf16_t* p, f32x4 v) { u32x2 o; o.x = pk2(v.x, v.y); o.y = pk2(v.z, v.w); *(u32x2*)p = o; }
struct EpiIn {
    static constexpr bool PERM = false, AFTER_DRAIN = false;
    bf16_t *Qg, *Kg, *Vg, *R, *Qd, *Kd, *VdT, *SA, *SB; const float* rope;
    __device__ __forceinline__ void operator()(const f32x4 (&acc)[2][2][4][2], const pg8::Unit& u, int wr, int wc, int fr, int fq) const {
        const int pn = u.pn, pm = u.pm;
        int sec, cb;
        if (pn < 4) { sec = 0; cb = pn * 256; } else if (pn < 8) { sec = 1; cb = (pn - 4) * 256; } else if (pn < 16) { sec = 2; cb = (pn - 8) * 256; } else if (pn < 24) { sec = 3; cb = (pn - 16) * 256; }
        else if (pn < 32) { sec = 4; cb = (pn - 24) * 256; } else if (pn < 40) { sec = 5; cb = (pn - 32) * 256; } else if (pn < 48) { sec = 6; cb = (pn - 40) * 256; } else if (pn < 56) { sec = 7; cb = (pn - 48) * 256; }
        else { sec = 8; cb = (pn - 56) * 256; }
        if (sec == 2 || sec == 6) {
            bf16_t* vb = (bf16_t*)((unsigned char*)Vg + (sec == 6 ? (WS_VDT - WS_VG) : (size_t)0));
#pragma unroll
            for (int ai = 0; ai < 2; ++ai) {
                const int r0 = pm * 256 + ai * 128 + wr * 64, b = r0 >> 11, s0 = r0 & 2047;
                const int pcol = (sec == 2) ? 64 + s0 + 4 * fr : permpos(16 + s0 + 4 * fr);
#pragma unroll
                for (int bj = 0; bj < 2; ++bj) {
                    bf16_t* d = vb + (size_t)(b * 2048 + cb + bj * 128 + wc * 32 + 4 * fq) * LKP + pcol;
#pragma unroll
                    for (int n = 0; n < 2; ++n)
#pragma unroll
                        for (int e = 0; e < 4; ++e) { u32x2 o; o.x = pk2(acc[ai][bj][0][n][e], acc[ai][bj][1][n][e]); o.y = pk2(acc[ai][bj][2][n][e], acc[ai][bj][3][n][e]);
                            *(u32x2*)(d + (size_t)(16 * n + e) * LKP) = o; }
                }
            }
            return;
        }
#pragma unroll
        for (int ai = 0; ai < 2; ++ai)
#pragma unroll
            for (int m = 0; m < 4; ++m) {
                const int r = pm * 256 + ai * 128 + wr * 64 + m * 16 + fr, b = r >> 11, s = r & 2047;
                const int pos = 16 + s;
                const int kpos = 16 + (s & ~63) + 4 * fr + m;
                const int pg = 64 + s;
#pragma unroll
                for (int bj = 0; bj < 2; ++bj) {
                    const int c0 = cb + bj * 128 + wc * 32 + 4 * fq;
                    f32x4 v0 = acc[ai][bj][m][0], v1 = acc[ai][bj][m][1];
                    if ((sec == 4 || sec == 5) && wc == 0) {
                        const f32x4 t0 = *(const f32x4*)(rope + (pos * 16 + 4 * fq) * 2), t1 = *(const f32x4*)(rope + (pos * 16 + 4 * fq) * 2 + 4);
                        const f32x4 cc = {t0.x, t0.z, t1.x, t1.z}, sn = {t0.y, t0.w, t1.y, t1.w};
                        const f32x4 a1 = v0 * cc - v1 * sn, a2 = v0 * sn + v1 * cc; v0 = a1; v1 = a2;
                    }
                    if (sec == 0) { bf16_t* d = Qg + (size_t)(b * LKP + pg) * 1024 + c0; st4bf(d, v0 * 0.0625f); st4bf(d + 16, v1 * 0.0625f); }
                    else if (sec == 1) { bf16_t* d = Kg + (size_t)(b * LKP + pg) * 1024 + c0; st4bf(d, v0); st4bf(d + 16, v1); }
                    else if (sec == 3) { bf16_t* d = R + (size_t)r * 2048 + c0; f32x4 g0, g1;
#pragma unroll
                        for (int e = 0; e < 4; ++e) { g0[e] = v0[e] * sigmoidf_(v0[e]); g1[e] = v1[e] * sigmoidf_(v1[e]); }
                        st4bf(d, g0); st4bf(d + 16, g1); }
                    else if (sec == 4) { bf16_t* d = Qd + (size_t)r * 2048 + c0; st4bf(d, v0 * C2Q); st4bf(d + 16, v1 * C2Q); }
                    else if (sec == 5) { bf16_t* d = Kd + (size_t)(b * LKP + kpos) * 2048 + c0; st4bf(d, v0); st4bf(d + 16, v1); }
                    else { bf16_t* d = SA + (size_t)(sec - 7) * ((WS_SB - WS_SA) / 2) + (size_t)r * 2048 + c0; f32x4 g0, g1;
#pragma unroll
                        for (int e = 0; e < 4; ++e) { g0[e] = sigmoidf_(v0[e]); g1[e] = sigmoidf_(v1[e]); }
                        st4bf(d, g0); st4bf(d + 16, g1); }
                }
            }
    }
};
DI void side_gemm(unsigned char* ws, int vcu, int G, int lane, int wave) {
    const bf16_t* A = (const bf16_t*)(ws + WS_A); const bf16_t* Bt = (const bf16_t*)(ws + WS_WTIN); const float* rope = (const float*)(ws + WS_ROPE);
    bf16_t* Kg = (bf16_t*)(ws + WS_KG); bf16_t* Vg = (bf16_t*)(ws + WS_VG); bf16_t* Kd = (bf16_t*)(ws + WS_KD); bf16_t* VdT = (bf16_t*)(ws + WS_VDT); float* LR = (float*)(ws + WS_LR);
    const int fr = lane & 15, g4 = lane >> 4;
    for (int it = wave * G + vcu; it < 737; it += G * 8) {
        int row0, col0;
        if (it < 513) { row0 = it * 16; col0 = 16384; }
        else { const int q = it - 513; row0 = 8192; col0 = q < 32 ? 1024 + q * 32 : q < 96 ? 2048 + (q - 32) * 32 : q < 160 ? 8192 + (q - 96) * 32 : 10240 + (q - 160) * 32; }
        const bf16_t* ap = A + (size_t)(row0 + fr) * 2048 + 8 * g4; const bf16_t* bp0 = Bt + (size_t)(col0 + fr) * 2048 + 8 * g4; const bf16_t* bp1 = bp0 + (size_t)16 * 2048;
        f32x4 acc0 = {0.f, 0.f, 0.f, 0.f}, acc1 = {0.f, 0.f, 0.f, 0.f};
#pragma unroll 8
        for (int ks = 0; ks < 64; ++ks) { const bf16x8 av = *(const bf16x8*)(ap + ks * 32), b0 = *(const bf16x8*)(bp0 + ks * 32), b1 = *(const bf16x8*)(bp1 + ks * 32); acc0 = MFMA16(av, b0, acc0); acc1 = MFMA16(av, b1, acc1); }
#pragma unroll
        for (int rg = 0; rg < 4; ++rg) { const int rl = 4 * g4 + rg; float x0 = acc0[rg], x1 = acc1[rg];
            if (it < 512) { const int r = row0 + rl, b = r >> 11, s = r & 2047; float* d = LR + (size_t)(b * LKP + 64 + s) * 32 + fr; d[0] = x0; d[16] = x1; }
            else if (it == 512) { for (int bb = 0; bb < NB; ++bb) { float* d = LR + (size_t)(bb * LKP + 48 + rl) * 32 + fr; d[0] = x0; d[16] = x1; } }
            else if (col0 < 2048) { for (int bb = 0; bb < NB; ++bb) { bf16_t* d = Kg + (size_t)(bb * LKP + 48 + rl) * 1024 + (col0 - 1024) + fr; d[0] = f2bf(x0); d[16] = f2bf(x1); } }
            else if (col0 < 4096) { for (int bb = 0; bb < NB; ++bb) { bf16_t* d = Vg + (size_t)(bb * 2048 + (col0 - 2048) + fr) * LKP + 4 * rl + 3; d[0] = f2bf(x0); d[(size_t)16 * LKP] = f2bf(x1); } }
            else if (col0 < 10240) { const int cs = col0 - 8192;
                if ((cs & 127) == 0) { const float c = rope[(rl * 16 + fr) * 2], sn = rope[(rl * 16 + fr) * 2 + 1]; const float a1 = x0 * c - x1 * sn, a2 = x0 * sn + x1 * c; x0 = a1; x1 = a2; }
                for (int bb = 0; bb < NB; ++bb) { bf16_t* d = Kd + (size_t)(bb * LKP + rl) * 2048 + cs + fr; d[0] = f2bf(x0); d[16] = f2bf(x1); } }
            else { const int cs = col0 - 10240, head = cs >> 8, dv = (cs & 255) + fr, pp = permpos(rl);
                for (int bb = 0; bb < NB; ++bb) { bf16_t* d = VdT + (size_t)((bb * 8 + head) * 256 + dv) * LKP + pp; d[0] = f2bf(x0); d[(size_t)16 * LKP] = f2bf(x1); } }
        }
    }
}

DI float logsig(float z) { return -(fmaxf(-z, 0.f) + __logf(1.0f + __expf(-fabsf(z)))); }
DI void gla_prep(LAS unsigned char* lds, int vcu, int G, int tid, int lane, int wave) {
    unsigned char* ws = WSB();
    LAS float* lrS = (LAS float*)lds;
    LAS bf16_t* qS = (LAS bf16_t*)(lds + 8192); LAS bf16_t* kS = (LAS bf16_t*)(lds + 8192 + 33792); LAS bf16_t* kstS = (LAS bf16_t*)(lds + 8192 + 2 * 33792);
    const bf16_t* Qg = (const bf16_t*)(ws + WS_QG); const bf16_t* Kg = (const bf16_t*)(ws + WS_KG); const float* LR = (const float*)(ws + WS_LR);
    bf16_t* QIN = (bf16_t*)(ws + WS_QIN); bf16_t* KST = (bf16_t*)(ws + WS_KST); bf16_t* AMAT = (bf16_t*)(ws + WS_AMAT); float* DEC = (float*)(ws + WS_DEC);
    const int fr = lane & 15, g4 = lane >> 4;
    for (int u = vcu; u < 1056; u += G) {
        const int dir = u / 528, rem = u % 528, bh = rem / 33, step = rem % 33;
        if (dir == 1 && step == 32) continue;
        const int b = bh >> 2, h = bh & 3, c = dir ? 32 - step : step, slot = (dir * 16 + bh) * 33 + step;
        const float* w2 = dir ? INP(6) : INP(4); const float* bia = dir ? INP(7) : INP(5);
        __syncthreads();
        if (tid < 256) { const int row = tid >> 2, q4 = tid & 3, p = dir ? 64 * c + 63 - row : 64 * c + row;
            *(LAS f32x4*)(lrS + row * 16 + 4 * q4) = *(const f32x4*)(LR + (size_t)(b * LKP + p) * 32 + dir * 16 + 4 * q4); }
#pragma unroll
        for (int i = 0; i < 4; ++i) { const int ck = tid + 512 * i, row = ck >> 5, cc = ck & 31, p = dir ? 64 * c + 63 - row : 64 * c + row;
            *(LAS u32x4*)((LAS unsigned char*)qS + row * 528 + cc * 16) = *(const u32x4*)(Qg + (size_t)(b * LKP + p) * 1024 + h * 256 + cc * 8);
            *(LAS u32x4*)((LAS unsigned char*)kS + row * 528 + cc * 16) = *(const u32x4*)(Kg + (size_t)(b * LKP + p) * 1024 + h * 256 + cc * 8); }
        float wb[2][4], bsv[2];
#pragma unroll
        for (int db = 0; db < 2; ++db) { const int d = h * 256 + (wave * 2 + db) * 16 + fr; bsv[db] = bia[d];
#pragma unroll
            for (int ks = 0; ks < 4; ++ks) wb[db][ks] = w2[(4 * ks + g4) * 1024 + d]; }
        __syncthreads();
        f32x4 lf[4][2];
#pragma unroll
        for (int tb = 0; tb < 4; ++tb) { float la[4];
#pragma unroll
            for (int ks = 0; ks < 4; ++ks) la[ks] = lrS[(tb * 16 + fr) * 16 + 4 * ks + g4];
#pragma unroll
            for (int db = 0; db < 2; ++db) { f32x4 z = {0.f, 0.f, 0.f, 0.f};
#pragma unroll
                for (int ks = 0; ks < 4; ++ks) z = __builtin_amdgcn_mfma_f32_16x16x4f32(la[ks], wb[db][ks], z, 0, 0, 0);
#pragma unroll
                for (int rg = 0; rg < 4; ++rg) { const int tau = tb * 16 + 4 * g4 + rg, p = dir ? 64 * c + 63 - tau : 64 * c + tau; z[rg] = (p < 48) ? 0.f : logsig(z[rg] + bsv[db]) * 0.0625f; }
                lf[tb][db] = z; } }
        float blast[2];
#pragma unroll
        for (int db = 0; db < 2; ++db) { float base = 0.f;
#pragma unroll
            for (int tb = 0; tb < 4; ++tb) { f32x4 v = lf[tb][db]; v[1] += v[0]; v[2] += v[1]; v[3] += v[2];
                const float t = v[3]; const float t0 = __shfl(t, fr), t1 = __shfl(t, fr + 16), t2 = __shfl(t, fr + 32), t3 = __shfl(t, fr + 48);
                const float off = base + (g4 > 0 ? t0 : 0.f) + (g4 > 1 ? t1 : 0.f) + (g4 > 2 ? t2 : 0.f);
                lf[tb][db] = v + off; base += (t0 + t1) + (t2 + t3); }
            blast[db] = base; }
#pragma unroll
        for (int db = 0; db < 2; ++db) { const int d = (wave * 2 + db) * 16 + fr;
            unsigned kq[4][4];
#pragma unroll
            for (int tb = 0; tb < 4; ++tb) {
#pragma unroll
                for (int rg = 0; rg < 4; ++rg) { const int tau = tb * 16 + 4 * g4 + rg; const float bc = lf[tb][db][rg];
                    const float qv = bf2f(qS[tau * 264 + d]), kv = bf2f(kS[tau * 264 + d]);
                    const float qi = qv * __expf(bc), ki = kv * __expf(-bc), ks = kv * __expf(blast[db] - bc);
                    qS[tau * 264 + d] = f2bf(qi); kS[tau * 264 + d] = f2bf(ki);
                    kq[tb][rg] = (unsigned)f2bf(ks); } }
#pragma unroll
            for (int rg = 0; rg < 4; ++rg) {
                if (dir) *(LAS u32x2*)((LAS unsigned char*)kstS + d * 144 + (16 * (3 - g4) + 4 * (3 - rg)) * 2) = (u32x2){kq[3][rg] | (kq[2][rg] << 16), kq[1][rg] | (kq[0][rg] << 16)};
                else *(LAS u32x2*)((LAS unsigned char*)kstS + d * 144 + (16 * g4 + 4 * rg) * 2) = (u32x2){kq[0][rg] | (kq[1][rg] << 16), kq[2][rg] | (kq[3][rg] << 16)}; }
            if (g4 == 0) DEC[slot * 256 + d] = __expf(blast[db]); }
        __syncthreads();
#pragma unroll
        for (int i = 0; i < 4; ++i) { const int ck = tid + 512 * i; *(u32x4*)(KST + (size_t)slot * 16384 + (ck >> 3) * 64 + (ck & 7) * 8) = *(const LAS u32x4*)((const LAS unsigned char*)kstS + (ck >> 3) * 144 + (ck & 7) * 16);
            *(u32x4*)(QIN + (size_t)slot * 16384 + (ck >> 5) * 256 + (ck & 31) * 8) = *(const LAS u32x4*)((const LAS unsigned char*)qS + (ck >> 5) * 528 + (ck & 31) * 16); }
        { const int tb = wave >> 1, sb0 = 2 * (wave & 1); f32x4 acc2[2];
#pragma unroll
            for (int q = 0; q < 2; ++q) { f32x4 acc = {0.f, 0.f, 0.f, 0.f};
#pragma unroll
                for (int ks = 0; ks < 8; ++ks) { const bf16x8 av = *(const LAS bf16x8*)(qS + (tb * 16 + fr) * 264 + ks * 32 + 8 * g4), bv8 = *(const LAS bf16x8*)(kS + ((sb0 + q) * 16 + fr) * 264 + ks * 32 + 8 * g4);
                    acc = MFMA16(av, bv8, acc); }
                acc2[q] = acc; }
#pragma unroll
            for (int rg = 0; rg < 4; ++rg) { const int tau = tb * 16 + 4 * g4 + rg, sig0 = sb0 * 16 + fr, sig1 = sig0 + 16;
                const float a0 = (dir ? (sig0 < tau) : (sig0 <= tau)) ? acc2[0][rg] : 0.f, a1 = (dir ? (sig1 < tau) : (sig1 <= tau)) ? acc2[1][rg] : 0.f;
                if (dir) *(unsigned*)(AMAT + (size_t)slot * 4096 + tau * 64 + 4 * (15 - fr) + 2 - sb0) = pk2(a1, a0);
                else *(unsigned*)(AMAT + (size_t)slot * 4096 + tau * 64 + 4 * fr + sb0) = pk2(a0, a1); } }
    }
}

constexpr int SC_QS = 0, SC_KT = 33792, SC_AS = 70656, SC_VT = 79872, SC_DEC = 89088, SC_OS = 90112;
DI void gla_scan(LAS unsigned char* lds, int vcu, int G, int tid, int lane, int wave) {
    unsigned char* ws = WSB();
    const bf16_t* QIN = (const bf16_t*)(ws + WS_QIN); const bf16_t* KST = (const bf16_t*)(ws + WS_KST); const bf16_t* AMAT = (const bf16_t*)(ws + WS_AMAT);
    const float* DEC = (const float*)(ws + WS_DEC); const bf16_t* Vg = (const bf16_t*)(ws + WS_VG);
    const int fr = lane & 15, g4 = lane >> 4, dvg = wave & 3, dkh = wave >> 2;
    LAS float* oS = (LAS float*)(lds + SC_OS);
    const float* cvU = INP(20); const float* cvV = INP(21); const float* cvG = INP(17);
    for (int u = vcu; u < 256; u += G) {
        const int dir = u >> 7, bh = (u >> 3) & 15, sl = u & 7, b = bh >> 2, h = bh & 3, nsteps = dir ? 32 : 33;
        bf16_t* Od = (bf16_t*)(ws + (dir ? WS_OB : WS_OF));
        f32x4 St[8];
#pragma unroll
        for (int i = 0; i < 8; ++i) St[i] = (f32x4){0.f, 0.f, 0.f, 0.f};
        u32x4 rq[4], rk[4], ra, rv; f32x4 rd = {0.f, 0.f, 0.f, 0.f};
        { const int slot = (dir * 16 + bh) * 33, c = dir ? 32 : 0; const int tau = tid >> 3, p = dir ? 64 * c + 63 - tau : 64 * c + tau;
#pragma unroll
          for (int i = 0; i < 4; ++i) { rq[i] = ((const u32x4*)(QIN + (size_t)slot * 16384))[tid + 512 * i]; rk[i] = ((const u32x4*)(KST + (size_t)slot * 16384))[tid + 512 * i]; }
          ra = ((const u32x4*)(AMAT + (size_t)slot * 4096))[tid]; rv = *(const u32x4*)(Vg + (size_t)(b * 2048 + h * 512 + sl * 64 + (tid >> 3)) * LKP + 64 * c + (tid & 7) * 8);
          if (tid < 64) rd = ((const f32x4*)(DEC + slot * 256))[tid]; }
        for (int step = 0; step < nsteps; ++step) {
            const int c = dir ? 32 - step : step;
#pragma unroll
            for (int i = 0; i < 4; ++i) { const int cq = tid + 512 * i; *(LAS u32x4*)(lds + SC_QS + (cq >> 5) * 528 + (cq & 31) * 16) = rq[i]; *(LAS u32x4*)(lds + SC_KT + (cq >> 3) * 144 + (cq & 7) * 16) = rk[i]; }
            *(LAS u32x4*)(lds + SC_AS + (tid >> 3) * 144 + (tid & 7) * 16) = ra;
            *(LAS u32x4*)(lds + SC_VT + (tid >> 3) * 144 + (tid & 7) * 16) = rv;
            if (tid < 64) *(LAS f32x4*)(lds + SC_DEC + tid * 16) = rd;
            __syncthreads();
            if (step + 1 < nsteps) { const int slot = (dir * 16 + bh) * 33 + step + 1, cn = dir ? 31 - step : step + 1; const int tau = tid >> 3, p = dir ? 64 * cn + 63 - tau : 64 * cn + tau;
#pragma unroll
                for (int i = 0; i < 4; ++i) { rq[i] = ((const u32x4*)(QIN + (size_t)slot * 16384))[tid + 512 * i]; rk[i] = ((const u32x4*)(KST + (size_t)slot * 16384))[tid + 512 * i]; }
                ra = ((const u32x4*)(AMAT + (size_t)slot * 4096))[tid]; rv = *(const u32x4*)(Vg + (size_t)(b * 2048 + h * 512 + sl * 64 + (tid >> 3)) * LKP + 64 * cn + (tid & 7) * 8);
                if (tid < 64) rd = ((const f32x4*)(DEC + slot * 256))[tid]; }
            f32x4 cvv[4]; const int cidx = step * 2048 + (vcu * 8 + wave); const bool cv_on = (G == 256) && cidx < 65536; const int ctab = cidx >> 15, cci = cidx & 32767;
            if (cv_on) { const f32x4* src = (const f32x4*)(ctab ? cvV : cvU) + (size_t)cci * 256 + lane;
#pragma unroll
                for (int q = 0; q < 4; ++q) cvv[q] = src[q * 64]; }
            const bool has_out = (c != 0);
            bf16x8 vb[2];
#pragma unroll
            for (int ks = 0; ks < 2; ++ks) vb[ks] = *(const LAS bf16x8*)(lds + SC_VT + (dvg * 16 + fr) * 144 + (ks * 32 + 8 * g4) * 2);
            if (has_out) {
                f32x4 ao[4];
#pragma unroll
                for (int tb = 0; tb < 4; ++tb) ao[tb] = (f32x4){0.f, 0.f, 0.f, 0.f};
#pragma unroll
                for (int ks = 0; ks < 4; ++ks) {
                    u32x4 bw; bw.x = pk2(St[2 * ks][0], St[2 * ks][1]); bw.y = pk2(St[2 * ks][2], St[2 * ks][3]); bw.z = pk2(St[2 * ks + 1][0], St[2 * ks + 1][1]); bw.w = pk2(St[2 * ks + 1][2], St[2 * ks + 1][3]);
                    const bf16x8 bs = __builtin_bit_cast(bf16x8, bw);
#pragma unroll
                    for (int tb = 0; tb < 4; ++tb) {
                        const LAS unsigned char* qp = lds + SC_QS + (tb * 16 + fr) * 528 + (dkh * 128 + ks * 32 + 4 * g4) * 2;
                        const u32x2 lo = *(const LAS u32x2*)qp, hi = *(const LAS u32x2*)(qp + 32);
                        const u32x4 aw = {lo.x, lo.y, hi.x, hi.y};
                        ao[tb] = MFMA16(__builtin_bit_cast(bf16x8, aw), bs, ao[tb]); }
                }
#pragma unroll
                for (int tb = 0; tb < 4; ++tb) if ((tb >> 1) == dkh) {
#pragma unroll
                    for (int ks = 0; ks < 2; ++ks) { const bf16x8 av = *(const LAS bf16x8*)(lds + SC_AS + (tb * 16 + fr) * 144 + (ks * 32 + 8 * g4) * 2); ao[tb] = MFMA16(av, vb[ks], ao[tb]); } }
#pragma unroll
                for (int tb = 0; tb < 4; ++tb)
#pragma unroll
                    for (int rg = 0; rg < 4; ++rg) oS[wave * 1024 + (tb * 16 + 4 * g4 + rg) * 16 + fr] = ao[tb][rg];
            }
#pragma unroll
            for (int kb = 0; kb < 8; ++kb) { const f32x4 dc = *(const LAS f32x4*)(lds + SC_DEC + (dkh * 128 + kb * 16 + 4 * g4) * 4); St[kb] = St[kb] * dc;
#pragma unroll
                for (int ks = 0; ks < 2; ++ks) { const bf16x8 av = *(const LAS bf16x8*)(lds + SC_KT + (dkh * 128 + kb * 16 + fr) * 144 + (ks * 32 + 8 * g4) * 2); St[kb] = MFMA16(av, vb[ks], St[kb]); } }
            __syncthreads();
            if (has_out) { const int tau = tid >> 3, c8 = tid & 7, dg = c8 >> 1, o8 = (c8 & 1) * 8; const int p = dir ? 64 * c + 63 - tau : 64 * c + tau, s = p - 64;
                const LAS float* p0 = oS + dg * 1024 + tau * 16 + o8; const LAS float* p1 = oS + (4 + dg) * 1024 + tau * 16 + o8;
                const f32x4 x0 = *(const LAS f32x4*)p0 + *(const LAS f32x4*)p1, x1 = *(const LAS f32x4*)(p0 + 4) + *(const LAS f32x4*)(p1 + 4);
                u32x4 o; o.x = pk2(x0.x, x0.y); o.y = pk2(x0.z, x0.w); o.z = pk2(x1.x, x1.y); o.w = pk2(x1.z, x1.w);
                *(u32x4*)(Od + (size_t)(b * SEQ + s) * 2048 + h * 512 + sl * 64 + c8 * 8) = o; }
            if (cv_on) { unsigned* dst = (unsigned*)(ws + (ctab ? WS_V : WS_U)) + (size_t)cci * 256 + lane;
#pragma unroll
                for (int q = 0; q < 4; ++q) { f32x4 x = cvv[q];
                    if (ctab) x = x * 64.0f; else x = x * (*(const f32x4*)(cvG + (cci & 1) * 1024 + q * 256 + lane * 4) * 1024.0f);
                    int w = __builtin_amdgcn_cvt_pk_fp8_f32(x.x, x.y, 0, false); w = __builtin_amdgcn_cvt_pk_fp8_f32(x.z, x.w, w, true); dst[q * 64] = (unsigned)w; } }
        }
        __syncthreads();
    }
}

constexpr int AT_K0 = 0, AT_KSZ = 34816, AT_V0 = 2 * 34816, AT_VSZ = 32768, AT_O2 = 0;
DI void attn_phase(LAS unsigned char* lds, int vcu, int G, int tid, int lane, int wave) {
    unsigned char* ws = WSB();
    const bf16_t* Qd = (const bf16_t*)(ws + WS_QD); bf16_t* Od = (bf16_t*)(ws + WS_OD); const bf16_t* Kd = (const bf16_t*)(ws + WS_KD); const bf16_t* VdT = (const bf16_t*)(ws + WS_VDT);
    const int fr = lane & 15, g4 = lane >> 4, map = wave >> 2, qs = wave & 3;
    const bool grpA = (map == 0);
    float lam;
    { float s1 = 0.f, s2 = 0.f; const float* l1 = INP(9); const float* l2 = INP(10); const float* l3 = INP(11); const float* l4 = INP(12);
      for (int i = 0; i < 128; ++i) { s1 += l1[i] * l2[i]; s2 += l3[i] * l4[i]; } lam = __expf(s1) - __expf(s2) + 0.2f; }
    const float* gno = INP(13);
    const unsigned koff = (unsigned)(tid >> 5) * 4096u + (unsigned)(tid & 31) * 16u, voff = (unsigned)(tid >> 3) * (unsigned)(LKP * 2) + (unsigned)(tid & 7) * 16u;
    const unsigned kdst = AT_K0 + (((tid & 31) >> 4) * 64 + (tid >> 5)) * 272 + (tid & 15) * 16, vdst = AT_V0 + (tid >> 3) * 128 + (((tid & 7) ^ ((tid >> 4) & 7)) * 16);
    const unsigned krd = AT_K0 + (map * 64 + fr) * 272 + g4 * 16;
    const unsigned vrd0 = AT_V0 + fr * 128 + ((g4 ^ ((fr >> 1) & 7)) * 16), vrd1 = AT_V0 + fr * 128 + (((4 + g4) ^ ((fr >> 1) & 7)) * 16);
    for (int u = vcu; u < 1024; u += G) {
        const int bh = u >> 5, qb = u & 31, b = bh >> 3, h = bh & 7, q0 = b * SEQ + qb * 64;
        bf16x8 qf[4];
#pragma unroll
        for (int ks = 0; ks < 4; ++ks) qf[ks] = *(const bf16x8*)(Qd + (size_t)(q0 + qs * 16 + fr) * 2048 + h * 256 + map * 128 + ks * 32 + 8 * g4);
        f32x4 oacc[16];
#pragma unroll
        for (int i = 0; i < 16; ++i) oacc[i] = (f32x4){0.f, 0.f, 0.f, 0.f};
        float mrun = 0.f, lrun = 0.f, mxp = -1e30f;
        u32x4 rk[4], rv[4]; bf16x8 bp[2]; f32x4 sacc[4];
        const unsigned char* kbase = (const unsigned char*)(Kd + (size_t)b * LKP * 2048 + h * 256);
        const unsigned char* vbase = (const unsigned char*)(VdT + (size_t)((b * 8 + h) * 256) * LKP);
#define AT_LOADK(tt) do { const unsigned char* kt_ = kbase + (size_t)((tt) * 64) * 4096; _Pragma("unroll") for (int i = 0; i < 4; ++i) rk[i] = *(const u32x4*)(kt_ + (size_t)(16 * i) * 4096 + koff); } while (0)
#define AT_LOADV(tt) do { const unsigned char* vt_ = vbase + (tt) * 128; _Pragma("unroll") for (int i = 0; i < 4; ++i) rv[i] = *(const u32x4*)(vt_ + (size_t)(64 * i) * (LKP * 2) + voff); } while (0)
#define AT_WRITEK(tt) do { const unsigned o_ = (unsigned)((tt) & 1) * AT_KSZ; _Pragma("unroll") for (int i = 0; i < 4; ++i) *(LAS u32x4*)(lds + o_ + kdst + i * (16 * 272)) = rk[i]; } while (0)
#define AT_WRITEV(tt) do { const unsigned o_ = (unsigned)((tt) & 1) * AT_VSZ; _Pragma("unroll") for (int i = 0; i < 4; ++i) *(LAS u32x4*)(lds + o_ + vdst + i * (64 * 128)) = rv[i]; } while (0)
#define AT_S_SM(tt) do { const unsigned ko_ = (unsigned)((tt) & 1) * AT_KSZ; \
            _Pragma("unroll") for (int kb = 0; kb < 4; ++kb) { sacc[kb] = (f32x4){0.f, 0.f, 0.f, 0.f}; \
                _Pragma("unroll") for (int ks = 0; ks < 4; ++ks) { const bf16x8 av = *(const LAS bf16x8*)(lds + ko_ + krd + kb * (16 * 272) + ks * 64); sacc[kb] = MFMA16(av, qf[ks], sacc[kb]); } } \
            __builtin_amdgcn_sched_barrier(0); \
            if ((tt) == 32) { sacc[1] = (f32x4){-1e30f, -1e30f, -1e30f, -1e30f}; sacc[2] = sacc[1]; sacc[3] = sacc[1]; } \
            mxp = -1e30f;        \
            _Pragma("unroll") for (int kb = 0; kb < 4; ++kb) mxp = fmaxf(fmaxf(mxp, fmaxf(sacc[kb][0], sacc[kb][1])), fmaxf(sacc[kb][2], sacc[kb][3])); \
            if ((tt) == 0) { float m0_ = fmaxf(mxp, __shfl_xor(mxp, 16)); mrun = fmaxf(m0_, __shfl_xor(m0_, 32)); }        \
            float rs = 0.f; \
            _Pragma("unroll") for (int kb = 0; kb < 4; ++kb) _Pragma("unroll") for (int j = 0; j < 4; ++j) { const float p = __builtin_amdgcn_exp2f(sacc[kb][j] - mrun); sacc[kb][j] = p; rs += p; } \
            lrun += rs; \
            _Pragma("unroll") for (int s2 = 0; s2 < 2; ++s2) { u32x4 pw; pw.x = pk2(sacc[2 * s2][0], sacc[2 * s2][1]); pw.y = pk2(sacc[2 * s2][2], sacc[2 * s2][3]); pw.z = pk2(sacc[2 * s2 + 1][0], sacc[2 * s2 + 1][1]); pw.w = pk2(sacc[2 * s2 + 1][2], sacc[2 * s2 + 1][3]); \
                bp[s2] = __builtin_bit_cast(bf16x8, pw); } \
            __builtin_amdgcn_sched_barrier(0); } while (0)
#define AT_PV(tt) do { const unsigned vo_ = (unsigned)((tt) & 1) * AT_VSZ; \
            _Pragma("unroll") for (int dq = 0; dq < 4; ++dq) { \
                _Pragma("unroll") for (int d4 = 0; d4 < 4; ++d4) { const int dvb = dq * 4 + d4; \
                    const bf16x8 a0 = *(const LAS bf16x8*)(lds + vo_ + vrd0 + dvb * 2048), a1 = *(const LAS bf16x8*)(lds + vo_ + vrd1 + dvb * 2048); \
                    oacc[dvb] = MFMA16(a0, bp[0], oacc[dvb]); oacc[dvb] = MFMA16(a1, bp[1], oacc[dvb]); } \
                __builtin_amdgcn_sched_barrier(0); } \
            { float mx = fmaxf(mxp, __shfl_xor(mxp, 16)); mx = fmaxf(mx, __shfl_xor(mx, 32));        \
              if (!__all(mx <= mrun + 4.0f)) { const float mnew = fmaxf(mrun, mx), alpha = __builtin_amdgcn_exp2f(mrun - mnew); mrun = mnew; lrun *= alpha; \
                  _Pragma("unroll") for (int i = 0; i < 16; ++i) oacc[i] = oacc[i] * alpha; } } } while (0)
        AT_LOADK(0); AT_LOADV(0);
        AT_WRITEK(0); AT_WRITEV(0);
        AT_LOADK(1); AT_LOADV(1);
        __syncthreads();
        for (int t = 0; t < 33; ++t) {
            if (grpA) { AT_S_SM(t); } else if (t > 0) { AT_PV(t - 1); }
            if (t + 1 < 33) AT_WRITEK(t + 1);
            if (t + 2 < 33) AT_LOADK(t + 2);
            __syncthreads();
            if (grpA) { AT_PV(t); } else { AT_S_SM(t); }
            if (t + 1 < 33) AT_WRITEV(t + 1);
            if (t + 2 < 33) AT_LOADV(t + 2);
            __syncthreads();
        }
        if (!grpA) { AT_PV(32); }
        __syncthreads();
#undef AT_LOADK
#undef AT_LOADV
#undef AT_WRITEK
#undef AT_WRITEV
#undef AT_S_SM
#undef AT_PV
        lrun += __shfl_xor(lrun, 16); lrun += __shfl_xor(lrun, 32);
        const float inv = 1.0f / lrun;
        LAS float* o2 = (LAS float*)(lds + AT_O2);
        const int q = qs * 16 + fr;
        if (map == 1) {
#pragma unroll
            for (int dvb = 0; dvb < 16; ++dvb) *(LAS f32x4*)(o2 + q * 260 + dvb * 16 + 4 * g4) = oacc[dvb] * inv;
        }
        __syncthreads();
        if (map == 0) {
            float ss = 0.f;
#pragma unroll
            for (int dvb = 0; dvb < 16; ++dvb) { const f32x4 v2 = *(const LAS f32x4*)(o2 + q * 260 + dvb * 16 + 4 * g4); const f32x4 o = oacc[dvb] * inv - v2 * lam; oacc[dvb] = o; ss += (o.x * o.x + o.y * o.y) + (o.z * o.z + o.w * o.w); }
            ss += __shfl_xor(ss, 16); ss += __shfl_xor(ss, 32);
            const float rstd = rsqrtf(ss * (1.0f / 256.0f) + EPSN) * 0.8f;
#pragma unroll
            for (int dvb = 0; dvb < 16; ++dvb) { const int dv0 = dvb * 16 + 4 * g4; const f32x4 g = *(const f32x4*)(gno + dv0); st4bf(Od + (size_t)(q0 + q) * 2048 + h * 256 + dv0, oacc[dvb] * g * rstd); }
        }
        __syncthreads();
    }
}

DI void gla_post(int vcu, int G, int lane, int wave) {
    unsigned char* ws = WSB(); const bf16_t* OF = (const bf16_t*)(ws + WS_OF); const bf16_t* OB = (const bf16_t*)(ws + WS_OB); const bf16_t* R = (const bf16_t*)(ws + WS_R); bf16_t* OG = (bf16_t*)(ws + WS_OG);
    const float* g = INP(8);
    const f32x4 g0 = *(const f32x4*)(g + lane * 8), g1 = *(const f32x4*)(g + lane * 8 + 4);
    for (int it = vcu * 8 + wave; it < TR * 4; it += G * 8) {
        const size_t off = (size_t)(it >> 2) * 2048 + (it & 3) * 512 + lane * 8;
        const u32x4 f = *(const u32x4*)(OF + off), bb = *(const u32x4*)(OB + off), rr = *(const u32x4*)(R + off);
        float o[8] = {bflo(f.x) + bflo(bb.x), bfhi(f.x) + bfhi(bb.x), bflo(f.y) + bflo(bb.y), bfhi(f.y) + bfhi(bb.y), bflo(f.z) + bflo(bb.z), bfhi(f.z) + bfhi(bb.z), bflo(f.w) + bflo(bb.w), bfhi(f.w) + bfhi(bb.w)};
        float s = 0.f;
#pragma unroll
        for (int e = 0; e < 8; ++e) s += o[e] * o[e];
        const float rstd = rsqrtf(wave_sum(s) * (1.0f / 512.0f) + EPSN);
        u32x4 w; w.x = pk2(o[0] * rstd * g0.x * bflo(rr.x), o[1] * rstd * g0.y * bfhi(rr.x)); w.y = pk2(o[2] * rstd * g0.z * bflo(rr.y), o[3] * rstd * g0.w * bfhi(rr.y));
        w.z = pk2(o[4] * rstd * g1.x * bflo(rr.z), o[5] * rstd * g1.y * bfhi(rr.z)); w.w = pk2(o[6] * rstd * g1.z * bflo(rr.w), o[7] * rstd * g1.w * bfhi(rr.w));
        *(u32x4*)(OG + off) = w;
    }
}

struct EpiBr1 {
    static constexpr bool PERM = true, AFTER_DRAIN = false; const bf16_t* SA; bf16_t* Y1;
    __device__ __forceinline__ void operator()(const f32x4 (&acc)[2][2][4][2], const pg8::Unit& u, int wr, int wc, int fr, int fq) const {
#pragma unroll
        for (int ai = 0; ai < 2; ++ai)
#pragma unroll
            for (int m = 0; m < 4; ++m)
#pragma unroll
                for (int bj = 0; bj < 2; ++bj) { const size_t off = (size_t)(u.pm * 256 + ai * 128 + wr * 64 + m * 16 + fr) * 2048 + u.pn * 256 + bj * 128 + wc * 32 + 8 * fq;
                    const u32x4 g = *(const u32x4*)(SA + off); const f32x4 v0 = acc[ai][bj][m][0], v1 = acc[ai][bj][m][1];
                    u32x4 o; o.x = pk2(v0.x * bflo(g.x), v0.y * bfhi(g.x)); o.y = pk2(v0.z * bflo(g.y), v0.w * bfhi(g.y)); o.z = pk2(v1.x * bflo(g.z), v1.y * bfhi(g.z)); o.w = pk2(v1.z * bflo(g.w), v1.w * bfhi(g.w));
                    *(u32x4*)(Y1 + off) = o; }
    }
};
struct EpiBr2 {
    static constexpr bool PERM = true, AFTER_DRAIN = false; const bf16_t* SB; const bf16_t* Y1; bf16_t* Y;
    __device__ __forceinline__ void operator()(const f32x4 (&acc)[2][2][4][2], const pg8::Unit& u, int wr, int wc, int fr, int fq) const {
#pragma unroll
        for (int ai = 0; ai < 2; ++ai)
#pragma unroll
            for (int m = 0; m < 4; ++m)
#pragma unroll
                for (int bj = 0; bj < 2; ++bj) { const size_t off = (size_t)(u.pm * 256 + ai * 128 + wr * 64 + m * 16 + fr) * 2048 + u.pn * 256 + bj * 128 + wc * 32 + 8 * fq;
                    const u32x4 g = *(const u32x4*)(SB + off), y = *(const u32x4*)(Y1 + off); const f32x4 v0 = acc[ai][bj][m][0], v1 = acc[ai][bj][m][1];
                    u32x4 o; o.x = pk2(bflo(y.x) + v0.x * bflo(g.x), bfhi(y.x) + v0.y * bfhi(g.x)); o.y = pk2(bflo(y.y) + v0.z * bflo(g.y), bfhi(y.y) + v0.w * bfhi(g.y));
                    o.z = pk2(bflo(y.z) + v1.x * bflo(g.z), bfhi(y.z) + v1.y * bfhi(g.z)); o.w = pk2(bflo(y.w) + v1.z * bflo(g.w), bfhi(y.w) + v1.w * bfhi(g.w));
                    *(u32x4*)(Y + off) = o; }
    }
};
struct EpiOut {
    static constexpr bool PERM = false, AFTER_DRAIN = false; const float* x; float* hs1; bf16_t* H1; float* ssq;
    __device__ __forceinline__ void operator()(const f32x4 (&acc)[2][2][4][2], const pg8::Unit& u, int wr, int wc, int fr, int fq) const {
#pragma unroll
        for (int ai = 0; ai < 2; ++ai)
#pragma unroll
            for (int m = 0; m < 4; ++m) { const int r = u.pm * 256 + ai * 128 + wr * 64 + m * 16 + fr; float s = 0.f;
#pragma unroll
                for (int bj = 0; bj < 2; ++bj)
#pragma unroll
                    for (int n = 0; n < 2; ++n) { const size_t off = (size_t)r * 2048 + u.pn * 256 + bj * 128 + wc * 32 + 16 * n + 4 * fq;
                        const f32x4 v = *(const f32x4*)(x + off) + acc[ai][bj][m][n]; st4bf(H1 + off, v); s += (v.x * v.x + v.y * v.y) + (v.z * v.z + v.w * v.w); }
                s += __shfl_xor(s, 16); s += __shfl_xor(s, 32);
                if (fq == 0) atomicAdd(ssq + r, s); }
    }
};
struct EpiQ {
    static constexpr bool PERM = true, AFTER_DRAIN = false; const float* ssq; bf16_t* Qp;
    __device__ __forceinline__ void operator()(const f32x4 (&acc)[2][2][4][2], const pg8::Unit& u, int wr, int wc, int fr, int fq) const {
#pragma unroll
        for (int ai = 0; ai < 2; ++ai)
#pragma unroll
            for (int m = 0; m < 4; ++m) { const int r = u.pm * 256 + ai * 128 + wr * 64 + m * 16 + fr; const float rstd = rsqrtf(ssq[r] * (1.0f / 2048.0f) + EPSN);
#pragma unroll
                for (int bj = 0; bj < 2; ++bj) { const size_t off = (size_t)r * 2048 + u.pn * 256 + bj * 128 + wc * 32 + 8 * fq; const f32x4 v0 = acc[ai][bj][m][0] * rstd, v1 = acc[ai][bj][m][1] * rstd;
                    u32x4 o; o.x = pk2(v0.x, v0.y); o.y = pk2(v0.z, v0.w); o.z = pk2(v1.x, v1.y); o.w = pk2(v1.z, v1.w); *(u32x4*)(Qp + off) = o; } }
    }
};

constexpr int TK_SV = 0, TK_SI = 8192, TK_V2 = 16384, TK_C2 = 20480, TK_TAB = 24576, TK_KEY = 32768;
DI unsigned sortable(float x) { const unsigned u = __float_as_uint(x); return u ^ ((unsigned)((int)u >> 31) | 0x80000000u); }
DI float unsortable(unsigned k) { return __uint_as_float((k & 0x80000000u) ? (k ^ 0x80000000u) : ~k); }
template <int PART> DI void peer_topk(LAS unsigned char* lds, int vcu, int G, int tid, int lane, int wave, int fpm = -1, int fpn = 0) {
    unsigned char* ws = WSB();
    if (PART & 1) { const float* U = INP(20); const float* V = INP(21); const float* gf = INP(17); unsigned* Ub = (unsigned*)(ws + WS_U); unsigned* Vb = (unsigned*)(ws + WS_V);
      for (int ci = vcu * 8 + wave; ci < 32768; ci += G * 8) { f32x4 uu[4], vv[4];
#pragma unroll
          for (int q = 0; q < 4; ++q) { uu[q] = ((const f32x4*)U)[(size_t)ci * 256 + q * 64 + lane]; vv[q] = ((const f32x4*)V)[(size_t)ci * 256 + q * 64 + lane]; }
#pragma unroll
          for (int q = 0; q < 4; ++q) { const f32x4 g = *(const f32x4*)(gf + (ci & 1) * 1024 + q * 256 + lane * 4) * 1024.0f; const f32x4 x = uu[q] * g, y = vv[q] * 64.0f;
              int w = __builtin_amdgcn_cvt_pk_fp8_f32(x.x, x.y, 0, false); w = __builtin_amdgcn_cvt_pk_fp8_f32(x.z, x.w, w, true); Ub[(size_t)ci * 256 + q * 64 + lane] = (unsigned)w;
              int w2 = __builtin_amdgcn_cvt_pk_fp8_f32(y.x, y.y, 0, false); w2 = __builtin_amdgcn_cvt_pk_fp8_f32(y.z, y.w, w2, true); Vb[(size_t)ci * 256 + q * 64 + lane] = (unsigned)w2; } } }
    if (!(PART & 2)) return;
    const bf16_t* Qp = (const bf16_t*)(ws + WS_QP); const bf16_t* KB = (const bf16_t*)(ws + WS_KEYS); int* IDX = (int*)(ws + WS_IDX); float* GATE = (float*)(ws + WS_GATE);
    LAS float* svS = (LAS float*)(lds + TK_SV); LAS int* siS = (LAS int*)(lds + TK_SI); LAS float* v2S = (LAS float*)(lds + TK_V2); LAS int* c2S = (LAS int*)(lds + TK_C2); LAS int* tabS = (LAS int*)(lds + TK_TAB);
    const int fr = lane & 15, g4 = lane >> 4;
    __syncthreads();
    if (tid < 64) { int cnt = 0, code = -1;
        for (int c = 0; c < 256; ++c) { const int i = c >> 4, j = c & 15; if ((i + 1) * (j + 1) <= 16) { if (cnt == tid) code = c; ++cnt; } }
        tabS[tid] = code; }
    const bool fusedq = fpm >= 0; const bool same_h = fusedq || (G % 8) == 0;
    if (same_h) { const int hh = fusedq ? fpn : (vcu & 7);
#pragma unroll
        for (int i = 0; i < 8; ++i) { const int ck = tid + 512 * i, row = ck >> 4, ch = ck & 15;
            *(LAS u32x4*)(lds + TK_KEY + row * 256 + ((ch ^ (row & 15)) * 16)) = *(const u32x4*)(KB + (size_t)(hh * 256 + row) * 128 + ch * 8); } }
    for (int u = fusedq ? 0 : vcu; u < (fusedq ? 4 : 1024); u += (fusedq ? 1 : G)) {
        const int h = fusedq ? fpn : (u & 7), t0 = fusedq ? fpm * 256 + u * 64 : (u >> 3) * 64;
        __syncthreads();
        { const int p = wave >> 2, tb = wave & 3; bf16x8 qf[4];
#pragma unroll
          for (int ks = 0; ks < 4; ++ks) qf[ks] = *(const bf16x8*)(Qp + (size_t)(t0 + tb * 16 + fr) * 2048 + h * 256 + p * 128 + ks * 32 + 8 * g4);
          unsigned key[32];
#pragma unroll
          for (int nb = 0; nb < 8; ++nb) { f32x4 acc = {0.f, 0.f, 0.f, 0.f};
#pragma unroll
              for (int ks = 0; ks < 4; ++ks) { const bf16x8 kv = same_h ? *(const LAS bf16x8*)(lds + TK_KEY + (p * 128 + nb * 16 + fr) * 256 + (((4 * ks + g4) ^ fr) * 16))
                                                                           : *(const bf16x8*)(KB + (size_t)((h * 2 + p) * 128 + nb * 16 + fr) * 128 + ks * 32 + 8 * g4); acc = MFMA16(kv, qf[ks], acc); }
#pragma unroll
              for (int rg = 0; rg < 4; ++rg) key[nb * 4 + rg] = (sortable(acc[rg]) & ~127u) | (unsigned)(127 - (nb * 16 + 4 * g4 + rg)); }
          unsigned prev = 0xffffffffu; const int t = tb * 16 + fr;
#pragma unroll 1
          for (int r = 0; r < 16; ++r) { unsigned m = 0u;
#pragma unroll
              for (int i = 0; i < 32; ++i) { const unsigned c = key[i] < prev ? key[i] : 0u; m = c > m ? c : m; }
              unsigned o = (unsigned)__shfl_xor((int)m, 16); m = o > m ? o : m; o = (unsigned)__shfl_xor((int)m, 32); m = o > m ? o : m;
              if (g4 == 0) { svS[(t * 2 + p) * 16 + r] = unsortable(m & ~127u); siS[(t * 2 + p) * 16 + r] = 127 - (int)(m & 127u); }
              prev = m; } }
        __syncthreads();
        if (tid < 256) { const int t = tid >> 2, q = tid & 3; unsigned key[13];
#pragma unroll
            for (int s = 0; s < 13; ++s) { const int c = q * 13 + s; const int code = tabS[c];
                const float x = svS[(t * 2) * 16 + ((code >> 4) & 15)] + svS[(t * 2 + 1) * 16 + (code & 15)];
                key[s] = code >= 0 ? ((sortable(x) & ~63u) | (unsigned)(63 - c)) : 0u; }
            unsigned prev = 0xffffffffu;
#pragma unroll 1
            for (int r = 0; r < 16; ++r) { unsigned m = 0u;
#pragma unroll
                for (int i = 0; i < 13; ++i) { const unsigned c = key[i] < prev ? key[i] : 0u; m = c > m ? c : m; }
                unsigned o = (unsigned)__shfl_xor((int)m, 1); m = o > m ? o : m; o = (unsigned)__shfl_xor((int)m, 2); m = o > m ? o : m;
                if (q == 0) { v2S[t * 16 + r] = unsortable(m & ~63u); c2S[t * 16 + r] = 63 - (int)(m & 63u); }
                prev = m; } }
        __syncthreads();
#pragma unroll
        for (int it = 0; it < 2; ++it) { const int t = (tid >> 4) + 32 * it, r = tid & 15;
            const float e = __expf(v2S[t * 16 + r] - v2S[t * 16]); float den = e;
            den += __shfl_xor(den, 1); den += __shfl_xor(den, 2); den += __shfl_xor(den, 4); den += __shfl_xor(den, 8);
            const int code = tabS[c2S[t * 16 + r]]; const size_t ob = ((size_t)(t0 + t) * 8 + h) * 16 + r;
            IDX[ob] = siS[(t * 2) * 16 + ((code >> 4) & 15)] * 128 + siS[(t * 2 + 1) * 16 + (code & 15)]; GATE[ob] = e / den; }
    }
}

DI void dec16(const u32x4 q, float* f) {
#pragma unroll
    for (int w = 0; w < 4; ++w) { const f32x2_t lo = __builtin_amdgcn_cvt_pk_f32_fp8((int)q[w], false), hi = __builtin_amdgcn_cvt_pk_f32_fp8((int)q[w], true); f[4 * w] = lo.x; f[4 * w + 1] = lo.y; f[4 * w + 2] = hi.x; f[4 * w + 3] = hi.y; }
}
DI void pick_apply(const u32x4 (&ur)[2], const u32x4 (&vr)[2], const float (&xv)[32], float (&acc)[32], float rstd, float gate) {
    float d = 0.f;
#pragma unroll
    for (int j = 0; j < 2; ++j) { float f[16]; dec16(ur[j], f);
#pragma unroll
        for (int q = 0; q < 16; ++q) d += f[q] * xv[j * 16 + q]; }
    d = wave_sum(d);
    const float w = gate * gelu_f(d * rstd) * (1.0f / 64.0f);
    __builtin_amdgcn_sched_barrier(0);
#pragma unroll
    for (int j = 0; j < 2; ++j) { float f[16]; dec16(vr[j], f);
#pragma unroll
        for (int q = 0; q < 16; ++q) acc[j * 16 + q] += w * f[q]; }
}
DI void peer_gather(LAS unsigned char* lds, int vcu, int G, int tid, int lane, int wave) {
    unsigned char* ws = WSB(); const unsigned char* U8 = ws + WS_U; const unsigned char* V8 = ws + WS_V; const int* IDX = (const int*)(ws + WS_IDX); const float* GATE = (const float*)(ws + WS_GATE);
    const float* ssq = (const float*)(ws + WS_SSQ); float* out = OUTP(); const float* gfin = INP(22); const bf16_t* H1 = (const bf16_t*)(ws + WS_H1);
    LAS unsigned* cnt = (LAS unsigned*)(lds + wave * 2048); LAS unsigned* srt = cnt + 256;
    const bool lockstep = (TR % (G * 8)) == 0;
    for (int t0 = vcu * 8 + wave; t0 < TR; t0 += G * 8) {
        int ln = lane; asm volatile("" : "+v"(ln));
        unsigned pay[2], pos[2];
#pragma unroll
        for (int q = 0; q < 2; ++q) { const int pi = ln + 64 * q; pay[q] = (unsigned)IDX[(size_t)t0 * 128 + pi] | ((unsigned)pi << 14); }
#pragma unroll
        for (int q = 0; q < 4; ++q) cnt[ln + 64 * q] = 0u;
        LDS_WAIT();
#pragma unroll
        for (int q = 0; q < 2; ++q) pos[q] = __hip_atomic_fetch_add(&cnt[(pay[q] & 16383u) >> 6], 1u, __ATOMIC_RELAXED, __HIP_MEMORY_SCOPE_WORKGROUP);
        LDS_WAIT();
        { const unsigned c0 = cnt[4 * ln], c1 = cnt[4 * ln + 1], c2 = cnt[4 * ln + 2], c3 = cnt[4 * ln + 3]; const unsigned tot = c0 + c1 + c2 + c3; unsigned inc = tot;
#pragma unroll
          for (int o = 1; o < 64; o <<= 1) { const unsigned v = (unsigned)__shfl_up((int)inc, o); if (ln >= o) inc += v; }
          const unsigned ex = inc - tot; LDS_WAIT();
          cnt[4 * ln] = ex; cnt[4 * ln + 1] = ex + c0; cnt[4 * ln + 2] = ex + c0 + c1; cnt[4 * ln + 3] = ex + c0 + c1 + c2; }
        LDS_WAIT();
#pragma unroll
        for (int q = 0; q < 2; ++q) srt[cnt[(pay[q] & 16383u) >> 6] + pos[q]] = pay[q];
        LDS_WAIT();
        float xv[32];
#pragma unroll
        for (int j = 0; j < 2; ++j)
#pragma unroll
            for (int q = 0; q < 2; ++q) { const u32x4 a = *(const u32x4*)(H1 + (size_t)t0 * 2048 + j * 1024 + ln * 16 + 8 * q); const int c = j * 16 + 8 * q;
                xv[c] = bflo(a.x); xv[c + 1] = bfhi(a.x); xv[c + 2] = bflo(a.y); xv[c + 3] = bfhi(a.y); xv[c + 4] = bflo(a.z); xv[c + 5] = bfhi(a.z); xv[c + 6] = bflo(a.w); xv[c + 7] = bfhi(a.w); }
        const float rstd = rsqrtf(ssq[t0] * (1.0f / 2048.0f) + EPSN) * (1.0f / 1024.0f);
        float acc[32];
#pragma unroll
        for (int i = 0; i < 32; ++i) acc[i] = 0.f;
        u32x4 ua[2], va[2], ub[2], vb[2], uc[2], vc[2], ud[2], vd[2]; float ga, gb, gc, gd;
#define PG_LOAD(UR, VR, GT, idx) do { if ((idx) < 128) { const unsigned pz = (unsigned)__builtin_amdgcn_readfirstlane((int)srt[(idx)]); const unsigned e = pz & 16383u; \
            _Pragma("unroll") for (int j = 0; j < 2; ++j) { UR[j] = *(const u32x4*)(U8 + (size_t)e * 2048 + j * 1024 + ln * 16); VR[j] = *(const u32x4*)(V8 + (size_t)e * 2048 + j * 1024 + ln * 16); } \
            GT = GATE[(size_t)t0 * 128 + (pz >> 14)]; } } while (0)
        PG_LOAD(ua, va, ga, 0); PG_LOAD(ub, vb, gb, 1); PG_LOAD(uc, vc, gc, 2);
#pragma unroll 1
        for (int i = 0; i < 128; i += 4) {
            if (lockstep && (i & 15) == 0) __builtin_amdgcn_s_barrier();
            PG_LOAD(ud, vd, gd, i + 3); __builtin_amdgcn_sched_barrier(0);
            pick_apply(ua, va, xv, acc, rstd, ga); __builtin_amdgcn_sched_barrier(0);
            PG_LOAD(ua, va, ga, i + 4); __builtin_amdgcn_sched_barrier(0);
            pick_apply(ub, vb, xv, acc, rstd, gb); __builtin_amdgcn_sched_barrier(0);
            PG_LOAD(ub, vb, gb, i + 5); __builtin_amdgcn_sched_barrier(0);
            pick_apply(uc, vc, xv, acc, rstd, gc); __builtin_amdgcn_sched_barrier(0);
            PG_LOAD(uc, vc, gc, i + 6); __builtin_amdgcn_sched_barrier(0);
            pick_apply(ud, vd, xv, acc, rstd, gd); __builtin_amdgcn_sched_barrier(0);
        }
#undef PG_LOAD
        { float* orow = out + (size_t)t0 * 2048 + ln * 16; float s = 0.f;
#pragma unroll
          for (int j = 0; j < 2; ++j)
#pragma unroll
              for (int q = 0; q < 16; ++q) acc[j * 16 + q] += xv[j * 16 + q];
#pragma unroll
          for (int i = 0; i < 32; ++i) s += acc[i] * acc[i];
          const float rs2 = rsqrtf(wave_sum(s) * (1.0f / 2048.0f) + EPSN); const float* gl = gfin + ln * 16;
#pragma unroll
          for (int j = 0; j < 2; ++j)
#pragma unroll
              for (int q = 0; q < 4; ++q) { const f32x4 g = *(const f32x4*)(gl + j * 1024 + 4 * q);
                  *(f32x4*)(orow + j * 1024 + 4 * q) = (f32x4){acc[j * 16 + 4 * q] * g.x * rs2, acc[j * 16 + 4 * q + 1] * g.y * rs2, acc[j * 16 + 4 * q + 2] * g.z * rs2, acc[j * 16 + 4 * q + 3] * g.w * rs2}; } }
    }
}

__global__ void __launch_bounds__(512, 2) mk_fwd(Args args) {
    extern __shared__ __attribute__((aligned(16))) unsigned char lds_raw[];
    LAS unsigned char* lds = (LAS unsigned char*)lds_raw;
    const int tid = threadIdx.x, lane = tid & 63, wave = __builtin_amdgcn_readfirstlane(tid >> 6);
    const int G = gridDim.x, bx = blockIdx.x;
    const int vcu = (G % 8 == 0) ? (bx % 8) * (G / 8) + bx / 8 : bx;
    cg::grid_group grid = cg::this_grid();
    unsigned char* ws = WSB();
    volatile LAS unsigned* xst = (volatile LAS unsigned*)(lds + (LDS_BYTES - 64));
    if (tid < 2) xst[tid] = 0u;
    __syncthreads();
    XcdBarrier xbar; xbar.bar = (unsigned*)(ws + WS_BAR); xbar.x = 0; xbar.st = xst;
    if (args.coop) xbar = xcd_barrier_post((unsigned*)(ws + WS_BAR), xst);
#ifndef PHMASK
#define PHMASK 0x3ff
#endif
#ifndef REP_PH
#define REP_PH -1
#endif
#define PH(k) (((PHMASK >> (k)) & 1) && args.ph_lo <= (k) && (k) < args.ph_hi)
#define SEAM(k) do { if (args.coop && PH(k) && PH((k) + 1)) { if (args.coop == 2) grid.sync(); else xcd_barrier(xbar); } } while (0)
    if (PH(0)) { { p0_prologue(lds, vcu, G, tid, lane, wave); }
#if REP_PH == 0
        grid.sync(); { p0_prologue(lds, vcu, G, tid, lane, wave); }
#endif
    } SEAM(0);
    if (PH(1)) { {
        pg8::Gemm g{(const bf16_t*)(ws + WS_A), (const bf16_t*)(ws + WS_WTIN), TR, 16384, 2048}; pg8::StaticOrder S; S.init(TR, 16384, G, bx);
        EpiIn E{(bf16_t*)(ws + WS_QG), (bf16_t*)(ws + WS_KG), (bf16_t*)(ws + WS_VG), (bf16_t*)(ws + WS_R), (bf16_t*)(ws + WS_QD), (bf16_t*)(ws + WS_KD), (bf16_t*)(ws + WS_VDT), (bf16_t*)(ws + WS_SA), (bf16_t*)(ws + WS_SB),
                (const float*)(ws + WS_ROPE)};
        pg8::gemm_phase<EpiIn, pg8::StaticOrder, true, true>(lds, g, S, E);
        side_gemm(ws, vcu, G, lane, wave);
    }
#if REP_PH == 1
        grid.sync(); {
        pg8::Gemm g{(const bf16_t*)(ws + WS_A), (const bf16_t*)(ws + WS_WTIN), TR, 16384, 2048}; pg8::StaticOrder S; S.init(TR, 16384, G, bx);
        EpiIn E{(bf16_t*)(ws + WS_QG), (bf16_t*)(ws + WS_KG), (bf16_t*)(ws + WS_VG), (bf16_t*)(ws + WS_R), (bf16_t*)(ws + WS_QD), (bf16_t*)(ws + WS_KD), (bf16_t*)(ws + WS_VDT), (bf16_t*)(ws + WS_SA), (bf16_t*)(ws + WS_SB),
                (const float*)(ws + WS_ROPE)};
        pg8::gemm_phase<EpiIn, pg8::StaticOrder, true, true>(lds, g, S, E);
        side_gemm(ws, vcu, G, lane, wave);
    }
#endif
    } SEAM(1);
    if (PH(2)) { { gla_prep(lds, vcu, G, tid, lane, wave); }
#if REP_PH == 2
        grid.sync(); { gla_prep(lds, vcu, G, tid, lane, wave); }
#endif
    } SEAM(2);
    if (PH(3)) { { gla_scan(lds, vcu, G, tid, lane, wave); attn_phase(lds, vcu, G, tid, lane, wave); }
#if REP_PH == 3
        grid.sync(); { gla_scan(lds, vcu, G, tid, lane, wave); attn_phase(lds, vcu, G, tid, lane, wave); }
#endif
#if REP_PH == 30
        grid.sync(); { gla_scan(lds, vcu, G, tid, lane, wave); }
#endif
#if REP_PH == 31
        grid.sync(); { attn_phase(lds, vcu, G, tid, lane, wave); }
#endif
    } SEAM(3);
    if (PH(4)) { { gla_post(vcu, G, lane, wave); }
#if REP_PH == 4
        grid.sync(); { gla_post(vcu, G, lane, wave); }
#endif
    } SEAM(4);
    if (PH(5)) { {
        { pg8::Gemm g{(const bf16_t*)(ws + WS_OG), (const bf16_t*)(ws + WS_WTA), TR, 2048, 2048}; pg8::StaticOrder S; S.init(TR, 2048, G, bx); EpiBr1 E{(const bf16_t*)(ws + WS_SA), (bf16_t*)(ws + WS_Y1)};
          pg8::gemm_phase<EpiBr1, pg8::StaticOrder, true, true>(lds, g, S, E); }
        __syncthreads();
        { pg8::Gemm g{(const bf16_t*)(ws + WS_OD), (const bf16_t*)(ws + WS_WTB), TR, 2048, 2048}; pg8::StaticOrder S; S.init(TR, 2048, G, bx); EpiBr2 E{(const bf16_t*)(ws + WS_SB), (const bf16_t*)(ws + WS_Y1), (bf16_t*)(ws + WS_Y)};
          pg8::gemm_phase<EpiBr2, pg8::StaticOrder, true, true>(lds, g, S, E); }
    }
#if REP_PH == 5
        grid.sync(); {
        { pg8::Gemm g{(const bf16_t*)(ws + WS_OG), (const bf16_t*)(ws + WS_WTA), TR, 2048, 2048}; pg8::StaticOrder S; S.init(TR, 2048, G, bx); EpiBr1 E{(const bf16_t*)(ws + WS_SA), (bf16_t*)(ws + WS_Y1)};
          pg8::gemm_phase<EpiBr1, pg8::StaticOrder, true, true>(lds, g, S, E); }
        __syncthreads();
        { pg8::Gemm g{(const bf16_t*)(ws + WS_OD), (const bf16_t*)(ws + WS_WTB), TR, 2048, 2048}; pg8::StaticOrder S; S.init(TR, 2048, G, bx); EpiBr2 E{(const bf16_t*)(ws + WS_SB), (const bf16_t*)(ws + WS_Y1), (bf16_t*)(ws + WS_Y)};
          pg8::gemm_phase<EpiBr2, pg8::StaticOrder, true, true>(lds, g, S, E); }
    }
#endif
    } SEAM(5);
    if (PH(6)) { { pg8::Gemm g{(const bf16_t*)(ws + WS_Y), (const bf16_t*)(ws + WS_WTO), TR, 2048, 2048}; pg8::StaticOrder S; S.init(TR, 2048, G, bx); EpiOut E{INP(0), OUTP(), (bf16_t*)(ws + WS_H1), (float*)(ws + WS_SSQ)};
        pg8::gemm_phase<EpiOut, pg8::StaticOrder, true, true>(lds, g, S, E); }
#if REP_PH == 6
        grid.sync(); { pg8::Gemm g{(const bf16_t*)(ws + WS_Y), (const bf16_t*)(ws + WS_WTO), TR, 2048, 2048}; pg8::StaticOrder S; S.init(TR, 2048, G, bx); EpiOut E{INP(0), OUTP(), (bf16_t*)(ws + WS_H1), (float*)(ws + WS_SSQ)};
        pg8::gemm_phase<EpiOut, pg8::StaticOrder, true, true>(lds, g, S, E); }
#endif
    } SEAM(6);
    if (PH(7)) { { pg8::Gemm g{(const bf16_t*)(ws + WS_H1), (const bf16_t*)(ws + WS_WTQ), TR, 2048, 2048}; pg8::StaticOrder S; S.init(TR, 2048, G, bx); EpiQ E{(const float*)(ws + WS_SSQ), (bf16_t*)(ws + WS_QP)};
        pg8::gemm_phase<EpiQ, pg8::StaticOrder, true, true>(lds, g, S, E);
        if (G == 256) { pg8::Unit u0; if (S.next(0, u0)) { asm volatile("s_waitcnt vmcnt(0)" ::: "memory"); __syncthreads(); peer_topk<2>(lds, vcu, G, tid, lane, wave, u0.pm, u0.pn); } } }
#if REP_PH == 7
        grid.sync(); { pg8::Gemm g{(const bf16_t*)(ws + WS_H1), (const bf16_t*)(ws + WS_WTQ), TR, 2048, 2048}; pg8::StaticOrder S; S.init(TR, 2048, G, bx); EpiQ E{(const float*)(ws + WS_SSQ), (bf16_t*)(ws + WS_QP)};
        pg8::gemm_phase<EpiQ, pg8::StaticOrder, true, true>(lds, g, S, E);
        if (G == 256) { pg8::Unit u0; if (S.next(0, u0)) { asm volatile("s_waitcnt vmcnt(0)" ::: "memory"); __syncthreads(); peer_topk<2>(lds, vcu, G, tid, lane, wave, u0.pm, u0.pn); } } }
#endif
    } SEAM(7);
    if (PH(8)) { { if (G != 256) peer_topk<3>(lds, vcu, G, tid, lane, wave); }
#if REP_PH == 8
        grid.sync(); { peer_topk<2>(lds, vcu, G, tid, lane, wave); }
#endif
#if REP_PH == 80
        grid.sync(); { peer_topk<1>(lds, vcu, G, tid, lane, wave); }
#endif
#if REP_PH == 81
        grid.sync(); { peer_topk<2>(lds, vcu, G, tid, lane, wave); }
#endif
    } if (G != 256) SEAM(8);
    if (PH(9)) { peer_gather(lds, vcu, G, tid, lane, wave); }
#undef PH
#undef SEAM
}

#ifndef MK_COOP
#define MK_COOP 1
#endif
extern "C" void kernel_launch(void* const* d_in, const int* in_sizes, int n_in, void* d_out, int out_size, void* d_ws, size_t ws_size, hipStream_t stream) {
    static int grid = 0;
    if (grid == 0) {
        if (n_in != 23 || out_size != TR * DM || ws_size < WS_END) { fprintf(stderr, "kernel_launch: unexpected problem (n_in %d, out %d, ws %zu)\n", n_in, out_size, ws_size); grid = -1; return; }
        int dev = 0, cus = 0, per_cu = 0;
        if (hipGetDevice(&dev) != hipSuccess || hipDeviceGetAttribute(&cus, hipDeviceAttributeMultiprocessorCount, dev) != hipSuccess) { grid = -1; return; }
        if (hipFuncSetAttribute((const void*)mk_fwd, hipFuncAttributeMaxDynamicSharedMemorySize, LDS_BYTES) != hipSuccess) { fprintf(stderr, "kernel_launch: hipFuncSetAttribute failed\n"); grid = -1; return; }
        if (hipOccupancyMaxActiveBlocksPerMultiprocessor(&per_cu, (const void*)mk_fwd, 512, LDS_BYTES) != hipSuccess || per_cu < 1) { fprintf(stderr, "kernel_launch: occupancy query says %d\n", per_cu); (void)hipGetLastError(); per_cu = 1; }
        grid = cus;
        if (grid % 8) grid -= grid % 8;
    }
    if (grid <= 0) return;
    Args a{};
    for (int i = 0; i < 23; ++i) a.in[i] = (const float*)d_in[i];
    a.out = (float*)d_out; a.ws = (unsigned char*)d_ws;
#if MK_COOP
    if (hipMemsetAsync((unsigned char*)d_ws + WS_BAR, 0, XCD_BAR_WORDS * 4, stream) != hipSuccess) { fprintf(stderr, "kernel_launch: hipMemsetAsync of the barrier words failed\n"); return; }
    a.ph_lo = 0; a.ph_hi = NPH; a.coop = 1;
    void* kargs[] = {&a};
    hipError_t e = hipLaunchCooperativeKernel((const void*)mk_fwd, dim3(grid), dim3(512), kargs, LDS_BYTES, stream);
    if (e != hipSuccess) fprintf(stderr, "cooperative launch failed: %s (grid %d)\n", hipGetErrorString(e), grid);
#else
    for (int p = 0; p < NPH; ++p) { a.ph_lo = p; a.ph_hi = p + 1; a.coop = 0; hipLaunchKernelGGL(mk_fwd, dim3(grid), dim3(512), LDS_BYTES, stream, a); }
#endif
}
```
